# Optimizing an MI355X kernel written in HIP

```python
import math
import jax
import jax.numpy as jnp
from jax import lax
import numpy as np

D_MODEL = 1024
BATCH = 16
SEQ = 2048
DEPTH = 2

MEM_LEN = 256

GROUP_WIDTH = D_MODEL // 4
MIX_WIDTH = 4 * GROUP_WIDTH

HG_HEADS = 4
HG_DK = GROUP_WIDTH // HG_HEADS
HG_DV = GROUP_WIDTH // HG_HEADS
HG_LB_FLOOR = 1e-20
GLA_HEADS = 4
GLA_DK = GROUP_WIDTH // (2 * GLA_HEADS)
GLA_DV = GROUP_WIDTH // GLA_HEADS
GLA_RANK = 16
GLA_TAU = 16.0
DA_HEADS = 4
DA_HD = GROUP_WIDTH // DA_HEADS
DA_ROT = DA_HD // 4
ROPE_THETA = 500000.0
DA_PATTERNS = ((128, 1), (512, 4), (2048, 16))
MASK_VALUE = -1e30
CONV_CH = GROUP_WIDTH
CONV_K = 31
X_HEADS = 4
X_HD = D_MODEL // X_HEADS
D_FF = ((int(8 * D_MODEL / 3) + 255) // 256) * 256

CHUNK = 64
EPS = 1e-6

IN_SPLITS = (
    HG_HEADS * HG_DK,
    HG_HEADS * HG_DK,
    HG_HEADS * HG_DV,
    HG_HEADS * HG_DV,
    GLA_HEADS * GLA_DK,
    GLA_HEADS * GLA_DK,
    GLA_HEADS * GLA_DV,
    GLA_RANK,
    GLA_HEADS * GLA_DV,
    DA_HEADS * DA_HD,
    DA_HEADS * DA_HD,
    DA_HEADS * DA_HD,
    CONV_CH,
    CONV_CH,
)
IN_WIDTH = sum(IN_SPLITS)

kernel_name = "hymba_style_hybrid_hgrn2_gla_dilated_conformer"


def rms_norm(x, g):
    xf = x.astype(jnp.float32)
    y = xf * lax.rsqrt(jnp.mean(xf * xf, axis=-1, keepdims=True) + EPS)
    return (y * g.astype(jnp.float32)).astype(x.dtype)


def swiglu_ffn(x, w_up, w_down):
    gate, up = jnp.split(x @ w_up, 2, axis=-1)
    return (jax.nn.silu(gate) * up) @ w_down


def chunked_gated_linear_attention(q, k, v, log_g):
    B, S, H, DK = q.shape
    DV = v.shape[-1]
    n = S // CHUNK

    def to_chunks(t):
        return t.astype(jnp.float32).reshape(B, n, CHUNK, H, t.shape[-1]).transpose(1, 0, 3, 2, 4)

    causal = jnp.tril(jnp.ones((CHUNK, CHUNK), dtype=bool))[:, :, None]

    def step(state, inp):
        qc, kc, vc, gc = inp
        b = jnp.cumsum(gc, axis=2)
        rel = b[:, :, :, None, :] - b[:, :, None, :, :]
        decay = jnp.where(causal, jnp.exp(jnp.where(causal, rel, 0.0)), 0.0)
        scores = jnp.einsum('bhtk,bhsk,bhtsk->bhts', qc, kc, decay)
        o = (jnp.einsum('bhts,bhsv->bhtv', scores, vc)
             + jnp.einsum('bhtk,bhkv->bhtv', qc * jnp.exp(b), state))
        b_last = b[:, :, -1:, :]
        state = (state * jnp.exp(b_last[:, :, 0, :, None])
                 + jnp.einsum('bhsk,bhsv->bhkv', kc * jnp.exp(b_last - b), vc))
        return state, o

    state0 = jnp.zeros((B, H, DK, DV), jnp.float32)
    _, o = lax.scan(step, state0, (to_chunks(q), to_chunks(k), to_chunks(v), to_chunks(log_g)))
    return o.transpose(1, 0, 3, 2, 4).reshape(B, S, H, DV).astype(v.dtype)


def hgrn2_mixer(q, f_pre, i, g, lb, out_gain):
    B, S, _ = q.shape
    q = q.reshape(B, S, HG_HEADS, HG_DK)
    z = f_pre.reshape(B, S, HG_HEADS, HG_DK).astype(jnp.float32)
    lb = lb.reshape(HG_HEADS, HG_DK)
    log_f = jnp.logaddexp(jnp.log(jnp.maximum(lb, HG_LB_FLOOR)),
                          jnp.log1p(-lb) + jax.nn.log_sigmoid(z))
    k = -jnp.expm1(log_f)
    v = i.reshape(B, S, HG_HEADS, HG_DV)
    o = chunked_gated_linear_attention(q, k, v, log_f)
    o = rms_norm(o, out_gain.reshape(HG_HEADS, HG_DV)) * jax.nn.silu(g.reshape(B, S, HG_HEADS, HG_DV))
    return o.reshape(B, S, HG_HEADS * HG_DV)


def gla_mixer(q, k, v, lr, r, gate_w, gate_b, out_gain):
    B, S, _ = q.shape
    q = q.reshape(B, S, GLA_HEADS, GLA_DK) * (GLA_DK ** -0.5)
    k = k.reshape(B, S, GLA_HEADS, GLA_DK)
    v = v.reshape(B, S, GLA_HEADS, GLA_DV)
    log_a = jax.nn.log_sigmoid((lr @ gate_w + gate_b).astype(jnp.float32)) / GLA_TAU
    log_a = log_a.reshape(B, S, GLA_HEADS, GLA_DK)
    o = chunked_gated_linear_attention(q, k, v, log_a)
    o = rms_norm(o, out_gain.reshape(GLA_HEADS, GLA_DV)) * jax.nn.silu(r.reshape(B, S, GLA_HEADS, GLA_DV))
    return o.reshape(B, S, GLA_HEADS * GLA_DV)


def partial_rope(t, cos, sin):
    half = DA_ROT // 2
    t1 = t[..., :half]
    t2 = t[..., half:DA_ROT]
    return jnp.concatenate([t1 * cos - t2 * sin, t2 * cos + t1 * sin, t[..., DA_ROT:]], axis=-1)


def dilated_branch(q, k, v, dilation, steps):
    B, S, H, hd = q.shape
    L = S // dilation
    n_blk = -(-L // steps)
    Lp = n_blk * steps

    def to_blocks(t):
        t = t.reshape(B, L, dilation, H, hd).transpose(0, 2, 3, 1, 4)
        t = jnp.pad(t, ((0, 0), (0, 0), (0, 0), (0, Lp - L), (0, 0)))
        return t.reshape(B, dilation, H, n_blk, steps, hd)

    def with_prev(t):
        prev = jnp.pad(t, ((0, 0), (0, 0), (0, 0), (1, 0), (0, 0), (0, 0)))[:, :, :, :-1]
        return jnp.concatenate([prev, t], axis=4)

    qb = to_blocks(q)
    kb = with_prev(to_blocks(k))
    vb = with_prev(to_blocks(v))
    s = jnp.einsum('bdhnqe,bdhnke->bdhnqk', qb, kb).astype(jnp.float32) * (hd ** -0.5)
    qi = jnp.arange(steps)[:, None]
    kj = jnp.arange(2 * steps)[None, :]
    steps_back = qi + steps - kj
    key_pos = jnp.arange(n_blk)[:, None, None] * steps - steps + kj
    valid = (steps_back >= 0) & (steps_back <= steps) & (key_pos >= 0)
    s = jnp.where(valid, s, MASK_VALUE)
    lse = jax.nn.logsumexp(s, axis=-1)
    p = jnp.exp(s - lse[..., None])
    o = jnp.einsum('bdhnqk,bdhnke->bdhnqe', p, vb.astype(jnp.float32))
    o = o.reshape(B, dilation, H, Lp, hd)[:, :, :, :L].transpose(0, 3, 1, 2, 4).reshape(B, S, H, hd)
    lse = lse.reshape(B, dilation, H, Lp)[..., :L].transpose(0, 3, 1, 2).reshape(B, S, H)
    return o, lse


def dilated_attention_mixer(q, k, v, cos, sin):
    B, S, _ = q.shape
    q = partial_rope(q.reshape(B, S, DA_HEADS, DA_HD), cos, sin)
    k = partial_rope(k.reshape(B, S, DA_HEADS, DA_HD), cos, sin)
    v = v.reshape(B, S, DA_HEADS, DA_HD)
    outs, lses = [], []
    for window, dilation in DA_PATTERNS:
        o, lse = dilated_branch(q, k, v, dilation, window // dilation)
        outs.append(o)
        lses.append(lse)
    weights = jax.nn.softmax(jnp.stack(lses, axis=0), axis=0)
    o = jnp.sum(weights[..., None] * jnp.stack(outs, axis=0), axis=0)
    return o.reshape(B, S, DA_HEADS * DA_HD).astype(q.dtype)


def conformer_conv_mixer(a, gate, conv_w, conv_b, ln_g, ln_b):
    u = a * jax.nn.sigmoid(gate)
    y = lax.conv_general_dilated(
        u, conv_w[:, None, :].astype(u.dtype), window_strides=(1,),
        padding=[(CONV_K - 1, 0)], dimension_numbers=('NWC', 'WIO', 'NWC'),
        feature_group_count=CONV_CH) + conv_b
    yf = y.astype(jnp.float32)
    mu = jnp.mean(yf, axis=-1, keepdims=True)
    var = jnp.mean(jnp.square(yf - mu), axis=-1, keepdims=True)
    yn = (yf - mu) * lax.rsqrt(var + EPS) * ln_g.astype(jnp.float32) + ln_b.astype(jnp.float32)
    return jax.nn.silu(yn).astype(a.dtype)


def memory_cross_attention(h, m, wq, wkv, wo):
    B, S, _ = h.shape
    M = m.shape[1]
    q = (h @ wq).reshape(B, S, X_HEADS, X_HD)
    k, v = jnp.split(m @ wkv, 2, axis=-1)
    k = k.reshape(B, M, X_HEADS, X_HD)
    v = v.reshape(B, M, X_HEADS, X_HD)
    s = jnp.einsum('bshd,bmhd->bhsm', q, k).astype(jnp.float32) * (X_HD ** -0.5)
    p = jax.nn.softmax(s, axis=-1)
    o = jnp.einsum('bhsm,bmhd->bshd', p.astype(v.dtype), v).reshape(B, S, D_MODEL)
    return o @ wo


def setup_inputs(seed: int = 0) -> dict:
    key = jax.random.key(seed)
    ks = iter(jax.random.split(key, 40))

    def nrm(shape, scale):
        return jax.random.normal(next(ks), shape, jnp.float32) * scale

    def gain(shape):
        return 1.0 + 0.02 * jax.random.normal(next(ks), shape, jnp.float32)

    offsets = jax.random.randint(next(ks), (BATCH, 1), 0, 1024, dtype=jnp.int32)
    positions = offsets + jnp.arange(SEQ, dtype=jnp.int32)[None, :]
    return {
        "x": nrm((BATCH, SEQ, D_MODEL), 1.0),
        "mem": nrm((BATCH, MEM_LEN, D_MODEL), 1.0),
        "positions": positions,
        "hgrn_lb_logits": nrm((DEPTH, HG_HEADS * HG_DK), 0.5),
        "ffn1_norm": gain((DEPTH, D_MODEL)),
        "ffn1_w_up": nrm((DEPTH, D_MODEL, 2 * D_FF), D_MODEL ** -0.5),
        "ffn1_w_down": nrm((DEPTH, D_FF, D_MODEL), D_FF ** -0.5),
        "mix_norm": gain((DEPTH, D_MODEL)),
        "w_in": nrm((DEPTH, D_MODEL, IN_WIDTH), D_MODEL ** -0.5),
        "hgrn_out_norm": gain((DEPTH, HG_HEADS * HG_DV)),
        "gla_gate_w": nrm((DEPTH, GLA_RANK, GLA_HEADS * GLA_DK), GLA_RANK ** -0.5),
        "gla_gate_b": nrm((DEPTH, GLA_HEADS * GLA_DK), 0.1),
        "gla_out_norm": gain((DEPTH, GLA_HEADS * GLA_DV)),
        "conv_w": nrm((DEPTH, CONV_K, CONV_CH), CONV_K ** -0.5),
        "conv_b": nrm((DEPTH, CONV_CH), 0.02),
        "conv_ln_g": gain((DEPTH, CONV_CH)),
        "conv_ln_b": nrm((DEPTH, CONV_CH), 0.02),
        "w_out": nrm((DEPTH, MIX_WIDTH, D_MODEL), MIX_WIDTH ** -0.5),
        "cross_norm": gain((DEPTH, D_MODEL)),
        "mem_norm": gain((DEPTH, D_MODEL)),
        "cross_wq": nrm((DEPTH, D_MODEL, D_MODEL), D_MODEL ** -0.5),
        "cross_wkv": nrm((DEPTH, D_MODEL, 2 * D_MODEL), D_MODEL ** -0.5),
        "cross_wo": nrm((DEPTH, D_MODEL, D_MODEL), D_MODEL ** -0.5),
        "ffn2_norm": gain((DEPTH, D_MODEL)),
        "ffn2_w_up": nrm((DEPTH, D_MODEL, 2 * D_FF), D_MODEL ** -0.5),
        "ffn2_w_down": nrm((DEPTH, D_FF, D_MODEL), D_FF ** -0.5),
        "final_norm": gain((D_MODEL,)),
    }


def reference(x, mem, positions, hgrn_lb_logits, ffn1_norm, ffn1_w_up, ffn1_w_down,
              mix_norm, w_in, hgrn_out_norm, gla_gate_w, gla_gate_b, gla_out_norm,
              conv_w, conv_b, conv_ln_g, conv_ln_b, w_out, cross_norm, mem_norm,
              cross_wq, cross_wkv, cross_wo, ffn2_norm, ffn2_w_up, ffn2_w_down, final_norm):
    inv_freq = jnp.power(jnp.float32(ROPE_THETA),
                         -jnp.arange(0, DA_ROT, 2, dtype=jnp.float32) / DA_ROT)
    ang = positions.astype(jnp.float32)[..., None] * inv_freq
    cos = jnp.cos(ang)[:, :, None, :].astype(x.dtype)
    sin = jnp.sin(ang)[:, :, None, :].astype(x.dtype)

    p_lb = jax.nn.softmax(hgrn_lb_logits.astype(jnp.float32), axis=0)
    lower_bounds = jnp.cumsum(p_lb, axis=0) - p_lb[0:1]

    split_points = [int(i) for i in np.cumsum(IN_SPLITS)[:-1]]

    for l in range(DEPTH):
        x = x + 0.5 * swiglu_ffn(rms_norm(x, ffn1_norm[l]), ffn1_w_up[l], ffn1_w_down[l])

        h = rms_norm(x, mix_norm[l])
        (hg_q, hg_f, hg_i, hg_g, gl_q, gl_k, gl_v, gl_lr, gl_r,
         da_q, da_k, da_v, cv_a, cv_g) = jnp.split(h @ w_in[l], split_points, axis=-1)

        o_a = hgrn2_mixer(hg_q, hg_f, hg_i, hg_g, lower_bounds[l], hgrn_out_norm[l])
        o_b = gla_mixer(gl_q, gl_k, gl_v, gl_lr, gl_r, gla_gate_w[l], gla_gate_b[l], gla_out_norm[l])
        o_c = dilated_attention_mixer(da_q, da_k, da_v, cos, sin)
        o_d = conformer_conv_mixer(cv_a, cv_g, conv_w[l], conv_b[l], conv_ln_g[l], conv_ln_b[l])
        x = x + jnp.concatenate([o_a, o_b, o_c, o_d], axis=-1) @ w_out[l]

        x = x + memory_cross_attention(rms_norm(x, cross_norm[l]), rms_norm(mem, mem_norm[l]),
                                       cross_wq[l], cross_wkv[l], cross_wo[l])

        x = x + 0.5 * swiglu_ffn(rms_norm(x, ffn2_norm[l]), ffn2_w_up[l], ffn2_w_down[l])

    return rms_norm(x, final_norm)
```

```cpp
#include <hip/hip_runtime.h>
#include <cstdio>
#include <cstdint>
namespace pg8 {
#define PG8_LAS __attribute__((address_space(3)))
typedef unsigned short bf16_t;
typedef short bf16x8 __attribute__((ext_vector_type(8)));
typedef float f32x4 __attribute__((ext_vector_type(4)));
typedef unsigned u32x4 __attribute__((ext_vector_type(4)));
constexpr int BM = 256, BK = 64, HALF = 128, HTB = HALF * BK * 2  , STAGE_BYTES = 8 * HTB, NXCD = 8, WGM = 8;

__host__ __device__ __forceinline__ int lds_byte(int r, int c) { const int st = (r >> 4) * 2 + (c >> 5), rr = r & 15, cc = c & 31, ob = rr * 64 + cc * 2; return st * 1024 + (ob ^ (((ob >> 9) & 1) << 5)); }
__host__ __device__ __forceinline__ void stage_rc(int b, int& R, int& C) { const int st = b / 1024, sb = b % 1024, swz = sb ^ (((sb >> 9) & 1) << 5); R = (st >> 1) * 16 + swz / 64; C = (st & 1) * 32 + (swz % 64) / 2; }
__host__ __device__ __forceinline__ int perm32(int rho) { const int n = rho >> 4, i = rho & 15; return 8 * (i >> 2) + 4 * n + (i & 3); }

struct Unit { int pm, pn; };
struct Gemm { const bf16_t* A; const bf16_t* Bt; int M, N, K; };

struct StaticOrder {
    int nM, nN, nwg, G, c;
    __host__ __device__ void init(int M, int N, int G_, int c_) { nM = M / BM; nN = N / BM; nwg = nM * nN; G = G_; c = c_; }
    __host__ __device__ bool next(int i, Unit& u) const {
        const long L = (long)i * G + c; if (L >= nwg) return false;
        int wgid = (int)L; { const int q = nwg / NXCD, r = nwg % NXCD, xcd = wgid % NXCD, off = wgid / NXCD; wgid = (xcd < r ? xcd * (q + 1) : r * (q + 1) + (xcd - r) * q) + off; }
        const int nig = WGM * nN, gid = wgid / nig, fm = gid * WGM, gsz = (nM - fm) < WGM ? (nM - fm) : WGM;
        u.pm = fm + ((wgid % nig) % gsz); u.pn = (wgid % nig) / gsz; return true;
    }
    __device__ __forceinline__ void a_ready(const Unit&) const {}
    __device__ __forceinline__ void done(const Unit&) const {}
};

__device__ __forceinline__ unsigned cvt_pk_bf16(float lo, float hi) { unsigned r; asm volatile("v_cvt_pk_bf16_f32 %0, %1, %2" : "=v"(r) : "v"(lo), "v"(hi)); return r; }
typedef float f32x2 __attribute__((ext_vector_type(2)));
typedef unsigned long long u64_t;
typedef _Float16 f16x8 __attribute__((ext_vector_type(8)));
typedef _Float16 f16x2_t __attribute__((ext_vector_type(2)));
__device__ __forceinline__ unsigned cvtpk_h(float lo, float hi) { f32x2 v = {lo, hi}; f16x2_t h = __builtin_convertvector(v, f16x2_t); return __builtin_bit_cast(unsigned, h); }
__device__ __forceinline__ f32x2 unpk_h(unsigned w) { f16x2_t h = __builtin_bit_cast(f16x2_t, w); return __builtin_convertvector(h, f32x2); }
typedef __bf16 bf16x2_t __attribute__((ext_vector_type(2)));
__device__ __forceinline__ unsigned cvtpk(float lo, float hi) { f32x2 v = {lo, hi}; bf16x2_t b = __builtin_convertvector(v, bf16x2_t); return __builtin_bit_cast(unsigned, b); }
typedef unsigned u32x2 __attribute__((ext_vector_type(2)));
constexpr float SSQ_SCALE = 1048576.0f;
__device__ __forceinline__ float rstd_from(u64_t v) { const float ms = ((float)(unsigned)(v >> 32) * 4294967296.0f + (float)(unsigned)v) * (1.0f / (SSQ_SCALE * 1024.0f)); return __builtin_amdgcn_rsqf(ms + 1e-6f); }
__device__ __forceinline__ float silu_f(float x) { return x * __builtin_amdgcn_rcpf(1.0f + __builtin_amdgcn_exp2f(-1.4426950408889634f * x)); }

struct EpiSwiglu {
    static constexpr bool PERM = true, AFTER_DRAIN = false;
    bf16_t* H; int ldh; const u64_t* ssq;
    __device__ __forceinline__ void operator()(const f32x4 (&acc)[2][2][4][2], const Unit& u, int wr, int wc, int fr, int fq) const {
        const int row0 = u.pm * BM + wr * 64 + fr, col0 = u.pn * HALF + wc * 32 + 8 * fq;
        u64_t sq[2][4];
#pragma unroll
        for (int ai = 0; ai < 2; ++ai)
#pragma unroll
            for (int m = 0; m < 4; ++m) sq[ai][m] = ssq[row0 + ai * HALF + m * 16];
#pragma unroll
        for (int ai = 0; ai < 2; ++ai)
#pragma unroll
            for (int m = 0; m < 4; ++m) { const int row = row0 + ai * HALF + m * 16; const float rs = rstd_from(sq[ai][m]);
                const f32x4 g0 = acc[ai][0][m][0] * rs, g1 = acc[ai][0][m][1] * rs, u0 = acc[ai][1][m][0] * rs, u1 = acc[ai][1][m][1] * rs;
                u32x4 w;
                w.x = cvtpk(silu_f(g0[0]) * u0[0], silu_f(g0[1]) * u0[1]); w.y = cvtpk(silu_f(g0[2]) * u0[2], silu_f(g0[3]) * u0[3]);
                w.z = cvtpk(silu_f(g1[0]) * u1[0], silu_f(g1[1]) * u1[1]); w.w = cvtpk(silu_f(g1[2]) * u1[2], silu_f(g1[3]) * u1[3]);
                *(u32x4*)(H + (size_t)row * ldh + col0) = w; }
    }
};
struct EpiResid {
    static constexpr bool PERM = true, AFTER_DRAIN = false;
    const float* X32; bf16_t* X16; u64_t* ssq_out; float scale;
    __device__ __forceinline__ void operator()(const f32x4 (&acc)[2][2][4][2], const Unit& u, int wr, int wc, int fr, int fq) const {
        const int row0 = u.pm * BM + wr * 64 + fr, col0 = u.pn * BM + wc * 32 + 8 * fq;
        if (X32) {
#pragma unroll
            for (int ai = 0; ai < 2; ++ai)
#pragma unroll
                for (int m = 0; m < 4; ++m) { const int row = row0 + ai * HALF + m * 16; bf16_t* hr = X16 + (size_t)row * 1024 + col0; float ss = 0.f;
#pragma unroll
                    for (int bj = 0; bj < 2; ++bj) { const float* xp = X32 + (size_t)row * 1024 + col0 + bj * HALF; f32x4 x0 = *(const f32x4*)xp, x1 = *(const f32x4*)(xp + 4);
                        x0 = x0 + acc[ai][bj][m][0] * scale; x1 = x1 + acc[ai][bj][m][1] * scale;
                        u32x4 w; w.x = cvtpk_h(x0[0], x0[1]); w.y = cvtpk_h(x0[2], x0[3]); w.z = cvtpk_h(x1[0], x1[1]); w.w = cvtpk_h(x1[2], x1[3]); *(u32x4*)(hr + bj * HALF) = w;
                        ss += ((x0[0] * x0[0] + x0[1] * x0[1]) + (x0[2] * x0[2] + x0[3] * x0[3])) + ((x1[0] * x1[0] + x1[1] * x1[1]) + (x1[2] * x1[2] + x1[3] * x1[3])); }
                    ss += __shfl_xor(ss, 16); ss += __shfl_xor(ss, 32);
                    if (fq == 0) atomicAdd(ssq_out + row, (u64_t)(ss * SSQ_SCALE + 0.5f));
                    asm volatile("" ::: "memory"); }
            return; }
#pragma unroll
        for (int ai = 0; ai < 2; ++ai) { u32x4 hv[4][2];
#pragma unroll
            for (int m = 0; m < 4; ++m)
#pragma unroll
                for (int bj = 0; bj < 2; ++bj) hv[m][bj] = *(const u32x4*)(X16 + (size_t)(row0 + ai * HALF + m * 16) * 1024 + col0 + bj * HALF);
#pragma unroll
            for (int m = 0; m < 4; ++m) { const int row = row0 + ai * HALF + m * 16; bf16_t* hr = X16 + (size_t)row * 1024 + col0; float ss = 0.f;
#pragma unroll
                for (int bj = 0; bj < 2; ++bj) { const u32x4 h4 = hv[m][bj]; const f32x2 a = unpk_h(h4.x), b = unpk_h(h4.y), c = unpk_h(h4.z), d = unpk_h(h4.w);
                    f32x4 x0 = (f32x4){a.x, a.y, b.x, b.y}, x1 = (f32x4){c.x, c.y, d.x, d.y};
                    x0 = x0 + acc[ai][bj][m][0] * scale; x1 = x1 + acc[ai][bj][m][1] * scale;
                    u32x4 w; w.x = cvtpk_h(x0[0], x0[1]); w.y = cvtpk_h(x0[2], x0[3]); w.z = cvtpk_h(x1[0], x1[1]); w.w = cvtpk_h(x1[2], x1[3]); *(u32x4*)(hr + bj * HALF) = w;
                    ss += ((x0[0] * x0[0] + x0[1] * x0[1]) + (x0[2] * x0[2] + x0[3] * x0[3])) + ((x1[0] * x1[0] + x1[1] * x1[1]) + (x1[2] * x1[2] + x1[3] * x1[3])); }
                ss += __shfl_xor(ss, 16); ss += __shfl_xor(ss, 32);
                if (fq == 0) atomicAdd(ssq_out + row, (u64_t)(ss * SSQ_SCALE + 0.5f)); }
            asm volatile("" ::: "memory"); }
    }
};
struct EpiProj {
    static constexpr bool PERM = true, AFTER_DRAIN = false;
    bf16_t* O; int ldo; const u64_t* ssq; const float* cs; const float* sn; int tq, tk; float qscale, gscale;
    __device__ __forceinline__ void operator()(const f32x4 (&acc)[2][2][4][2], const Unit& u, int wr, int wc, int fr, int fq) const {
        const int row0 = u.pm * BM + wr * 64 + fr, col0 = u.pn * BM + wc * 32 + 8 * fq;
        const bool rope = (u.pn == tq || u.pn == tk) && ((wc & 1) == 0) && (fq < 2);
        const float osc = ((u.pn == tq) ? qscale : 1.0f) * gscale;
        u64_t sq[2][4];
#pragma unroll
        for (int ai = 0; ai < 2; ++ai)
#pragma unroll
            for (int m = 0; m < 4; ++m) sq[ai][m] = ssq[row0 + ai * HALF + m * 16];
#pragma unroll
        for (int g = 0; g < 4; ++g) { const int ai = g >> 1; f32x4 cr[2], sr[2];
#pragma unroll
            for (int mm = 0; mm < 2; ++mm) { const int row = row0 + ai * HALF + (2 * (g & 1) + mm) * 16; cr[mm] = (f32x4){1.f, 1.f, 1.f, 1.f}; sr[mm] = (f32x4){0.f, 0.f, 0.f, 0.f};
                if (rope) { cr[mm] = *(const f32x4*)(cs + (size_t)row * 8 + 4 * fq); sr[mm] = *(const f32x4*)(sn + (size_t)row * 8 + 4 * fq); } }
#pragma unroll
            for (int mm = 0; mm < 2; ++mm) { const int m = 2 * (g & 1) + mm; const int row = row0 + ai * HALF + m * 16; const float rs = rstd_from(sq[ai][m]) * osc;
                const f32x4 c4 = cr[mm], s4 = sr[mm];
#pragma unroll
                for (int bj = 0; bj < 2; ++bj) { const f32x4 a = acc[ai][bj][m][0] * rs, b = acc[ai][bj][m][1] * rs;
                    const f32x4 v0 = rope ? (a * c4 - b * s4) : a, v1 = rope ? (b * c4 + a * s4) : b;
                    u32x4 w; w.x = cvtpk(v0[0], v0[1]); w.y = cvtpk(v0[2], v0[3]); w.z = cvtpk(v1[0], v1[1]); w.w = cvtpk(v1[2], v1[3]);
                    *(u32x4*)(O + (size_t)row * ldo + col0 + bj * HALF) = w; } } }
    }
};
struct EpiKV {
    static constexpr bool PERM = true, AFTER_DRAIN = false;
    bf16_t* O; int ldo; int tpm, tpn; size_t lstride;
    __device__ __forceinline__ void operator()(const f32x4 (&acc)[2][2][4][2], const Unit& u, int wr, int wc, int fr, int fq) const {
        const int l = u.pm / tpm; bf16_t* base = O + (size_t)l * lstride;
        const int row0 = (u.pm - l * tpm) * BM + wr * 64 + fr, col0 = (u.pn - l * tpn) * BM + wc * 32 + 8 * fq;
#pragma unroll
        for (int ai = 0; ai < 2; ++ai)
#pragma unroll
            for (int m = 0; m < 4; ++m) { bf16_t* rowp = base + (size_t)(row0 + ai * HALF + m * 16) * ldo + col0;
#pragma unroll
                for (int bj = 0; bj < 2; ++bj) { const f32x4 v0 = acc[ai][bj][m][0], v1 = acc[ai][bj][m][1];
                    u32x4 w; w.x = cvtpk(v0[0], v0[1]); w.y = cvtpk(v0[2], v0[3]); w.z = cvtpk(v1[0], v1[1]); w.w = cvtpk(v1[2], v1[3]);
                    *(u32x4*)(rowp + bj * HALF) = w; } }
    }
};
struct DiagOrder {
    int tpm, tpn, nl, G, c;
    __device__ __forceinline__ bool next(int i, Unit& u) const {
        const int L = i * G + c, per = tpm * tpn; if (L >= nl * per) return false;
        const int l = L / per, r = L % per; u.pm = l * tpm + r % tpm; u.pn = l * tpn + r / tpm; return true; }
    __device__ __forceinline__ void a_ready(const Unit&) const {}
    __device__ __forceinline__ void done(const Unit&) const {}
};
template <class Epi, class Sched, bool ALIGN_EPI = false, bool SP2 = false, bool F16 = false>
__device__ __forceinline__ void gemm_phase(PG8_LAS unsigned char* lds, const Gemm g, const Sched& S, const Epi& E) {
    int tid_l = threadIdx.x; asm volatile("" : "+v"(tid_l));
    const int tid = tid_l, wid = __builtin_amdgcn_readfirstlane(tid >> 6), lane = tid & 63, wr = wid >> 2, wc = wid & 3, fr = lane & 15, fq = lane >> 4;
    const int K = g.K, nt = K / BK;
    unsigned voffA[2], voffB[2];
#pragma unroll
    for (int i = 0; i < 2; ++i) { int R, C; stage_rc(tid * 16 + i * 8192, R, C); const int Rb = Epi::PERM ? ((R & ~31) + perm32(R & 31)) : R;
        voffA[i] = (unsigned)(R * K + C) * 2u; voffB[i] = (unsigned)(Rb * K + C) * 2u; }
    const size_t kstep = (size_t)(BK * 2);
    const size_t hstep = (size_t)HALF * K * 2;
    const size_t tstep = 2 * hstep;
    const unsigned ldsw = (unsigned)wid * 1024u;
    const int aoff = lds_byte(wr * 64 + fr, fq * 8), boff = lds_byte(wc * 32 + fr, fq * 8);
#define PG8_SA(b, h) (((b) * 2 + (h)) * HTB)
#define PG8_SB(b, h) ((4 + (b) * 2 + (h)) * HTB)
#define PG8_STAGE(bufoff, gbase, voff) do { _Pragma("unroll") for (int _i = 0; _i < 2; ++_i) \
        __builtin_amdgcn_global_load_lds((const unsigned*)((const char*)(gbase) + (voff)[_i]), (PG8_LAS unsigned*)(lds + (bufoff) + ldsw + _i * 8192), 16, 0, 0); } while (0)
#define PG8_LDA(dst, b, h) do { _Pragma("unroll") for (int m = 0; m < 4; ++m) _Pragma("unroll") for (int k = 0; k < 2; ++k) dst[m][k] = *(const PG8_LAS bf16x8*)(lds + PG8_SA(b, h) + aoff + m * 2048 + k * 1024); } while (0)
#define PG8_LDB(dst, b, h) do { _Pragma("unroll") for (int n = 0; n < 2; ++n) _Pragma("unroll") for (int k = 0; k < 2; ++k) dst[n][k] = *(const PG8_LAS bf16x8*)(lds + PG8_SB(b, h) + boff + n * 2048 + k * 1024); } while (0)
#define PG8_MMA(ai, bj, At, Bt) do { __builtin_amdgcn_s_setprio(1); _Pragma("unroll") for (int m = 0; m < 4; ++m) _Pragma("unroll") for (int n = 0; n < 2; ++n) _Pragma("unroll") for (int k = 0; k < 2; ++k) \
        acc[ai][bj][m][n] = F16 ? __builtin_amdgcn_mfma_f32_16x16x32_f16(__builtin_bit_cast(f16x8, Bt[n][k]), __builtin_bit_cast(f16x8, At[m][k]), acc[ai][bj][m][n], 0, 0, 0) \
                                : __builtin_amdgcn_mfma_f32_16x16x32_bf16(Bt[n][k], At[m][k], acc[ai][bj][m][n], 0, 0, 0); __builtin_amdgcn_s_setprio(0); } while (0)
#define PG8_WAIT_V(n) asm volatile("s_waitcnt vmcnt(" #n ")" ::: "memory")
#define PG8_WAIT_L(n) asm volatile("s_waitcnt lgkmcnt(" #n ")" ::: "memory")
#define PG8_BAR __builtin_amdgcn_s_barrier()
#define PG8_SCHED __builtin_amdgcn_sched_barrier(0)
    Unit cur, nxt; int ui = 0;
    if (!S.next(0, cur)) return;
    f32x4 acc[2][2][4][2];
#pragma unroll
    for (int a = 0; a < 2; ++a)
#pragma unroll
        for (int b = 0; b < 2; ++b)
#pragma unroll
            for (int m = 0; m < 4; ++m)
#pragma unroll
                for (int n = 0; n < 2; ++n) acc[a][b][m][n] = (f32x4){0.f, 0.f, 0.f, 0.f};
    bf16x8 At[4][2], B0[2][2], B1[2][2];
    const char* cA = (const char*)g.A + (size_t)cur.pm * tstep; const char* cB = (const char*)g.Bt + (size_t)cur.pn * tstep;
    S.a_ready(cur);
    if constexpr (SP2) {
        PG8_STAGE(PG8_SB(0, 0), cB, voffB); PG8_STAGE(PG8_SB(0, 1), cB + hstep, voffB); PG8_STAGE(PG8_SA(0, 0), cA, voffA); PG8_STAGE(PG8_SA(0, 1), cA + hstep, voffA);
        if (wr == 1) PG8_BAR;
        PG8_WAIT_V(2); PG8_BAR;
        PG8_STAGE(PG8_SB(1, 0), cB + kstep, voffB); PG8_STAGE(PG8_SA(1, 0), cA + kstep, voffA); PG8_STAGE(PG8_SB(1, 1), cB + hstep + kstep, voffB);
        PG8_WAIT_V(6); PG8_BAR;
    } else {
        PG8_STAGE(PG8_SB(0, 0), cB, voffB); PG8_STAGE(PG8_SA(0, 0), cA, voffA); PG8_STAGE(PG8_SB(0, 1), cB + hstep, voffB); PG8_STAGE(PG8_SA(0, 1), cA + hstep, voffA);
        if (wr == 1) PG8_BAR;
        PG8_WAIT_V(4); PG8_BAR;
        PG8_STAGE(PG8_SB(1, 0), cB + kstep, voffB); PG8_STAGE(PG8_SA(1, 0), cA + kstep, voffA); PG8_STAGE(PG8_SB(1, 1), cB + hstep + kstep, voffB);
        PG8_WAIT_V(6); PG8_BAR;
    }
    for (;;) {
        const bool has_next = S.next(ui + 1, nxt);
        const char* nA = has_next ? (const char*)g.A + (size_t)nxt.pm * tstep : cA; const char* nB = has_next ? (const char*)g.Bt + (size_t)nxt.pn * tstep : cB;
        for (int t = 0; t < nt; t += 2) {
            const bool last = (t == nt - 2);
            const char* a1 = cA + (size_t)(t + 1) * kstep;
            const char* a2 = last ? nA : cA + (size_t)(t + 2) * kstep; const char* b2 = last ? nB : cB + (size_t)(t + 2) * kstep;
            const char* a3 = a2 + kstep; const char* b3 = b2 + kstep;
            if (last && has_next) S.a_ready(nxt);
            if constexpr (SP2) {
            PG8_LDB(B0, 0, 0); PG8_LDB(B1, 0, 1); PG8_SCHED; PG8_LDA(At, 0, 0); PG8_STAGE(PG8_SA(1, 1), a1 + hstep, voffA);
            PG8_WAIT_V(8); PG8_WAIT_L(0); PG8_BAR; PG8_MMA(0, 0, At, B0); PG8_MMA(0, 1, At, B1); PG8_BAR; PG8_SCHED;
            PG8_LDA(At, 0, 1); PG8_STAGE(PG8_SB(0, 0), b2, voffB); PG8_STAGE(PG8_SB(0, 1), b2 + hstep, voffB); PG8_STAGE(PG8_SA(0, 0), a2, voffA);
            PG8_WAIT_V(8); PG8_WAIT_L(0); PG8_BAR; PG8_MMA(1, 0, At, B0); PG8_MMA(1, 1, At, B1); PG8_BAR; PG8_SCHED;
            PG8_LDB(B0, 1, 0); PG8_LDB(B1, 1, 1); PG8_SCHED; PG8_LDA(At, 1, 0); PG8_STAGE(PG8_SA(0, 1), a2 + hstep, voffA);
            PG8_WAIT_V(8); PG8_WAIT_L(0); PG8_BAR; PG8_MMA(0, 0, At, B0); PG8_MMA(0, 1, At, B1); PG8_BAR; PG8_SCHED;
            PG8_LDA(At, 1, 1); PG8_STAGE(PG8_SB(1, 0), b3, voffB); PG8_STAGE(PG8_SB(1, 1), b3 + hstep, voffB); PG8_STAGE(PG8_SA(1, 0), a3, voffA);
            PG8_WAIT_V(8); PG8_WAIT_L(0); PG8_BAR; PG8_MMA(1, 0, At, B0); PG8_MMA(1, 1, At, B1); PG8_BAR; PG8_SCHED;
            } else {
            PG8_LDB(B0, 0, 0); PG8_SCHED; PG8_LDA(At, 0, 0); PG8_STAGE(PG8_SA(1, 1), a1 + hstep, voffA);
            PG8_WAIT_L(8); PG8_BAR; PG8_WAIT_L(0); PG8_MMA(0, 0, At, B0); PG8_BAR; PG8_SCHED;
            PG8_LDB(B1, 0, 1); PG8_STAGE(PG8_SB(0, 0), b2, voffB);
            PG8_BAR; PG8_WAIT_L(0); PG8_MMA(0, 1, At, B1); PG8_BAR;
            PG8_LDA(At, 0, 1); PG8_STAGE(PG8_SA(0, 0), a2, voffA);
            PG8_BAR; PG8_WAIT_L(0); PG8_MMA(1, 0, At, B0); PG8_BAR; PG8_SCHED;
            PG8_STAGE(PG8_SB(0, 1), b2 + hstep, voffB);
            PG8_WAIT_V(6); PG8_BAR; PG8_MMA(1, 1, At, B1); PG8_BAR;
            PG8_LDB(B0, 1, 0); PG8_SCHED; PG8_LDA(At, 1, 0); PG8_STAGE(PG8_SA(0, 1), a2 + hstep, voffA);
            PG8_WAIT_L(8); PG8_BAR; PG8_WAIT_L(0); PG8_MMA(0, 0, At, B0); PG8_BAR; PG8_SCHED;
            PG8_LDB(B1, 1, 1); PG8_STAGE(PG8_SB(1, 0), b3, voffB);
            PG8_BAR; PG8_WAIT_L(0); PG8_MMA(0, 1, At, B1); PG8_BAR;
            PG8_LDA(At, 1, 1); PG8_STAGE(PG8_SA(1, 0), a3, voffA);
            PG8_BAR; PG8_WAIT_L(0); PG8_MMA(1, 0, At, B0); PG8_BAR; PG8_SCHED;
            PG8_STAGE(PG8_SB(1, 1), b3 + hstep, voffB);
            PG8_WAIT_V(6); PG8_BAR; PG8_MMA(1, 1, At, B1); PG8_BAR;
            }
        }
        if constexpr (ALIGN_EPI) { if (wr == 0) PG8_BAR; }
        if constexpr (!Epi::AFTER_DRAIN) { E(acc, cur, wr, wc, fr, fq); S.done(cur); }
        if (!has_next) break;
#pragma unroll
        for (int a = 0; a < 2; ++a)
#pragma unroll
            for (int b = 0; b < 2; ++b)
#pragma unroll
                for (int m = 0; m < 4; ++m)
#pragma unroll
                    for (int n = 0; n < 2; ++n) acc[a][b][m][n] = (f32x4){0.f, 0.f, 0.f, 0.f};
        cur = nxt; cA = nA; cB = nB; ++ui;
        if constexpr (ALIGN_EPI) { if (wr == 1) PG8_BAR; }
    }
    PG8_WAIT_V(0);
    if constexpr (!ALIGN_EPI) { if (wr == 0) PG8_BAR; }
    PG8_BAR;
    if constexpr (Epi::AFTER_DRAIN) { E.fused(acc, cur, wr, wc, fr, fq, lds, wid, lane); S.done(cur); }
#undef PG8_SA
#undef PG8_SB
#undef PG8_STAGE
#undef PG8_LDA
#undef PG8_LDB
#undef PG8_MMA
#undef PG8_WAIT_V
#undef PG8_WAIT_L
#undef PG8_BAR
#undef PG8_SCHED
}
}
#define XB_TMO      128
#define XB_XCNT(j)  (256  + 64 * (j))
#define XB_XSUB(j)  (1280 + 64 * (j))
#define XB_XGEN(j)  (2304 + 64 * (j))
#define XB_TOP      3328
#define XB_TOPGEN   3392
#define XCD_BAR_WORDS 3456
#define XB_SPIN_CAP (1u << 18)
#define LAS __attribute__((address_space(3)))

__device__ __forceinline__ unsigned xb_ld(unsigned* p)              { return __hip_atomic_load(p, __ATOMIC_RELAXED, __HIP_MEMORY_SCOPE_AGENT); }
__device__ __forceinline__ unsigned xb_add(unsigned* p, unsigned v) { return __hip_atomic_fetch_add(p, v, __ATOMIC_RELAXED, __HIP_MEMORY_SCOPE_AGENT); }
__device__ __forceinline__ unsigned xb_xcc_id() { return (unsigned)__builtin_amdgcn_s_getreg((3 << 11) | 20) & 0xFu; }
#define XB_SPIN(cond, bar) do { unsigned _sp = 0; while (cond) { __builtin_amdgcn_s_sleep(1); \
    if ((++_sp & 255u) == 0u) { if (xb_ld(&(bar)[XB_TMO])) break; if (_sp > XB_SPIN_CAP) { atomicAdd(&(bar)[XB_TMO], 1u); break; } } } } while (0)

struct XcdBarrier {
    unsigned* bar; unsigned x;
    volatile LAS unsigned* st;
};

__device__ __forceinline__ XcdBarrier xcd_barrier_post(unsigned* bar, volatile LAS unsigned* st) {
    XcdBarrier b; b.bar = bar; b.x = xb_xcc_id(); b.st = st;
    if (threadIdx.x == 0) (void)xb_add(&bar[XB_XCNT(b.x)], 1u);
    return b;
}
__device__ __forceinline__ void xcd_barrier_complete(unsigned* bar, unsigned x, unsigned& nloc, unsigned& nx) {
    const unsigned G = gridDim.x * gridDim.y * gridDim.z;
    unsigned sum, cnt, mine, sp = 0u;
    for (;;) {
        sum = 0u; cnt = 0u; mine = 0u;
#pragma unroll
        for (unsigned j = 0; j < 16; ++j) { const unsigned c = xb_ld(&bar[XB_XCNT(j)]); sum += c; cnt += (c > 0u) ? 1u : 0u; mine = (j == x) ? c : mine; }
        if (sum == G) break;
        __builtin_amdgcn_s_sleep(1);
        if ((++sp & 255u) == 0u) { if (xb_ld(&bar[XB_TMO])) break; if (sp > XB_SPIN_CAP) { atomicAdd(&bar[XB_TMO], 1u); break; } }
    }
    nloc = mine > 0u ? mine : 1u; nx = cnt > 0u ? cnt : 1u;
}

__device__ __forceinline__ void xcd_barrier(const XcdBarrier& b) {
    asm volatile("s_waitcnt vmcnt(0)" ::: "memory");
    __syncthreads();
    if (threadIdx.x == 0) {
        unsigned* bar = b.bar;
        __builtin_amdgcn_s_waitcnt(0);
        asm volatile("buffer_inv sc1" ::: "memory");
        unsigned nloc = b.st[0], nx = b.st[1];
        if (nloc == 0u) { xcd_barrier_complete(bar, b.x, nloc, nx); b.st[0] = nloc; b.st[1] = nx; }
        const unsigned old = xb_add(&bar[XB_XSUB(b.x)], 1u);
        const unsigned gen = old / nloc;
        if (old - gen * nloc == (nloc >> 1)) asm volatile("buffer_wbl2 sc1" ::: "memory");
        if (old + 1u == (gen + 1u) * nloc) {
            __builtin_amdgcn_fence(__ATOMIC_RELEASE, "agent");
            asm volatile("s_waitcnt vmcnt(0)" ::: "memory");
            const unsigned og = xb_add(&bar[XB_TOP], 1u);
            const unsigned tg = og / nx;
            if (og + 1u == (tg + 1u) * nx) xb_add(&bar[XB_TOPGEN], 1u);
            else XB_SPIN(xb_ld(&bar[XB_TOPGEN]) == tg, bar);
            asm volatile("" ::: "memory");
            xb_add(&bar[XB_XGEN(b.x)], 1u);
            asm volatile("s_waitcnt vmcnt(0)" ::: "memory");
        } else {
            XB_SPIN(xb_ld(&bar[XB_XGEN(b.x)]) == gen, bar);
            asm volatile("" ::: "memory");
            asm volatile("s_waitcnt vmcnt(0)" ::: "memory");
        }
    }
    __syncthreads();
}
constexpr int NWAVES = 8, NTHR = 512;
constexpr int BATCH = 16, SEQ = 2048, D = 1024, M = BATCH * SEQ, DFF = 2816, NUP = 2 * DFF, MEMLEN = 256, MROWS = BATCH * MEMLEN, DEPTH = 2;
constexpr int NIN = 3072;
constexpr int C_HQ = 0, C_HF = 256, C_HI = 512, C_HG = 768, C_GQ = 1024, C_GK = 1152, C_GV = 1280, C_GR = 1536, C_DQ = 1792, C_DK = 2048, C_DV = 2304, C_CA = 2560, C_CG = 2816;
constexpr float EPS = 1e-6f, LOG2E = 1.4426950408889634f;

constexpr size_t MiB = 1u << 20;
constexpr size_t WS_CTL = 0, CTL_ZERO_BYTES = 4 * MiB;
constexpr size_t WS_SSQ = 1 * MiB;
constexpr size_t SZ_W1 = (size_t)NUP * D * 2, SZ_W2 = (size_t)D * DFF * 2, SZ_WIN = (size_t)NIN * D * 2, SZ_SQ = (size_t)D * D * 2;
constexpr size_t WS_W1 = 4 * MiB;
constexpr size_t WS_W2 = WS_W1 + DEPTH * SZ_W1;
constexpr size_t WS_W3 = WS_W2 + DEPTH * SZ_W2;
constexpr size_t WS_W4 = WS_W3 + DEPTH * SZ_W1;
constexpr size_t WS_WIN = WS_W4 + DEPTH * SZ_W2;
constexpr size_t WS_WOUT = WS_WIN + DEPTH * SZ_WIN;
constexpr size_t WS_WQ = WS_WOUT + DEPTH * SZ_SQ;
constexpr size_t WS_WK = WS_WQ + DEPTH * SZ_SQ;
constexpr size_t WS_WV = WS_WK + DEPTH * SZ_SQ;
constexpr size_t WS_WO = WS_WV + DEPTH * SZ_SQ;
constexpr size_t WS_WEND = WS_WO + DEPTH * SZ_SQ;
constexpr size_t WS_MEMN = 104 * MiB;
constexpr size_t WS_KB = WS_MEMN + 16 * MiB;
constexpr size_t WS_VT = WS_KB + 16 * MiB;
constexpr size_t WS_ROPE = WS_VT + 16 * MiB;
constexpr size_t WS_TAB_LB = WS_ROPE + 2 * MiB, WS_TAB_GW = WS_TAB_LB + 4096, WS_WLR = WS_TAB_LB + 65536, WS_LR = WS_TAB_LB + 262144;
constexpr size_t WS_XB = 156 * MiB;
constexpr size_t WS_MIX = WS_XB + 64 * MiB;
constexpr size_t WS_BIG = WS_MIX + 64 * MiB;
constexpr size_t WS_END = WS_BIG + 208 * MiB;
static_assert(WS_WEND <= WS_MEMN && WS_LR + (size_t)M * 16 * 2 <= WS_XB && WS_END <= 512 * MiB && (size_t)M * NIN * 2 <= 208 * MiB, "d_ws map");
constexpr int CW_BAR = 4096;
constexpr int CW_WQ = 16384;

constexpr int RING_BYTES = 131072, XATT_BYTES = 256 * 528, MISC_OFF = 139264 + 320, LDS_BYTES = 147456;
static_assert(XATT_BYTES <= 139264 && MISC_OFF + 256 <= LDS_BYTES, "LDS map");

typedef unsigned short bf16;
typedef unsigned v4u __attribute__((ext_vector_type(4)));
typedef unsigned v2u __attribute__((ext_vector_type(2)));
typedef float f32x4 __attribute__((ext_vector_type(4)));
typedef float f32x16 __attribute__((ext_vector_type(16)));
typedef short bf16x8 __attribute__((ext_vector_type(8)));
typedef short s16x4 __attribute__((ext_vector_type(4)));
typedef unsigned long long u64;
#define LDS_WAIT() asm volatile("s_waitcnt lgkmcnt(0)" ::: "memory")
__device__ __forceinline__ unsigned f2bf(float f) { unsigned u = __builtin_bit_cast(unsigned, f); return (u + 0x7fffu + ((u >> 16) & 1u)) >> 16; }
__device__ __forceinline__ unsigned pk2(float lo, float hi) { return f2bf(lo) | (f2bf(hi) << 16); }
__device__ __forceinline__ float bf2f(unsigned short b) { return __builtin_bit_cast(float, (unsigned)b << 16); }
__device__ __forceinline__ float wave_sum(float v) {
#pragma unroll
    for (int o = 1; o < 64; o <<= 1) v += __shfl_xor(v, o);
    return v;
}
__device__ __forceinline__ float sigmoid_f(float x) { return __builtin_amdgcn_rcpf(1.0f + __builtin_amdgcn_exp2f(-LOG2E * x)); }
__device__ __forceinline__ float silu2(float x) { return x * sigmoid_f(x); }
__device__ __forceinline__ float logsig(float z) { return fminf(z, 0.f) - log1pf(expf(-fabsf(z))); }
__device__ __forceinline__ int crow(int r, int hi) { return (r & 3) + 8 * (r >> 2) + 4 * hi; }

struct Args { const float* in[27]; float* out; unsigned char* ws; };

__device__ __forceinline__ int map_up(int n) { const int pn = n >> 8, j = n & 255; return (j < 128) ? 128 * pn + j : DFF + 128 * pn + (j - 128); }
__device__ __forceinline__ int rope_src(int j) { const int hd = j >> 6, dd = j & 63; const int sd = (dd < 4 || dd >= 12) ? dd : (dd < 8 ? dd + 4 : dd - 4); return hd * 64 + sd; }
__device__ __forceinline__ int map_win(int n) {
    if (n < 1536) return n;
    if (n < 1792) return n + 16;
    if (n < 2048) return 1808 + rope_src(n - 1792);
    if (n < 2304) return 2064 + rope_src(n - 2048);
    return n + 16;
}
template <int MAPK, bool F16>
__device__ __forceinline__ void transpose_item(const float* W, int ldw, int coloff, const float* gain, bf16* WT, int K, LAS float* scr, int kb, int nb, int lane) {
    const int k0 = 64 * kb, n0 = 64 * nb; const int n = n0 + lane;
    const int src = (MAPK == 0) ? n : (MAPK == 1 ? map_up(n) : map_win(n));
    const float* wp = W + (size_t)k0 * ldw + coloff + src;
#pragma unroll 1
    for (int h = 0; h < 2; ++h) { float v[32];
#pragma unroll
        for (int i = 0; i < 32; ++i) v[i] = wp[(size_t)(32 * h + i) * ldw];
        if (gain) {
#pragma unroll
            for (int i = 0; i < 32; ++i) v[i] *= gain[k0 + 32 * h + i]; }
#pragma unroll
        for (int i = 0; i < 32; ++i) { const int kk = 32 * h + i; scr[kk * 64 + (lane ^ (kk & 31))] = v[i]; } }
    LDS_WAIT(); asm volatile("" ::: "memory");
    const int c = lane & 7;
#pragma unroll
    for (int j = 0; j < 8; ++j) { const int nn = (lane >> 3) + 8 * j; float x[8];
#pragma unroll
        for (int i = 0; i < 8; ++i) { const int kk = 8 * c + i; x[i] = scr[kk * 64 + (nn ^ (kk & 31))]; }
        v4u o;
        if (F16) { o.x = pg8::cvtpk_h(x[0], x[1]); o.y = pg8::cvtpk_h(x[2], x[3]); o.z = pg8::cvtpk_h(x[4], x[5]); o.w = pg8::cvtpk_h(x[6], x[7]); }
        else { o.x = pk2(x[0], x[1]); o.y = pk2(x[2], x[3]); o.z = pk2(x[4], x[5]); o.w = pk2(x[6], x[7]); }
        *(v4u*)(WT + (size_t)(n0 + nn) * K + k0 + 8 * c) = o; }
    LDS_WAIT(); asm volatile("" ::: "memory");
}
__device__ __forceinline__ void p0_prologue(const Args& A, LAS unsigned char* L, int G) {
    int tid = threadIdx.x; asm volatile("" : "+v"(tid));
    const int lane = tid & 63, wave = __builtin_amdgcn_readfirstlane(tid >> 6);
    unsigned char* ws = A.ws;
    LAS float* scr = (LAS float*)(L + wave * 16384);
    const int gw = blockIdx.x * NWAVES + wave, NGW = G * NWAVES;
    constexpr int I_UP = (D / 64) * (NUP / 64), I_DN = (DFF / 64) * (D / 64), I_IN = (D / 64) * (NIN / 64), I_SQ = (D / 64) * (D / 64);
    constexpr int PER_L = 2 * I_UP + 2 * I_DN + I_IN + 5 * I_SQ;
    for (int it = gw; it < DEPTH * PER_L; it += NGW) {
        const int l = it / PER_L; int r = it % PER_L;
        if (r < I_UP) { transpose_item<1, true>(A.in[5] + (size_t)l * D * NUP, NUP, 0, A.in[4] + l * D, (bf16*)(ws + WS_W1 + l * SZ_W1), D, scr, r / (NUP / 64), r % (NUP / 64), lane); continue; } r -= I_UP;
        if (r < I_UP) { transpose_item<1, true>(A.in[24] + (size_t)l * D * NUP, NUP, 0, A.in[23] + l * D, (bf16*)(ws + WS_W3 + l * SZ_W1), D, scr, r / (NUP / 64), r % (NUP / 64), lane); continue; } r -= I_UP;
        if (r < I_DN) { transpose_item<0, false>(A.in[6] + (size_t)l * DFF * D, D, 0, nullptr, (bf16*)(ws + WS_W2 + l * SZ_W2), DFF, scr, r / (D / 64), r % (D / 64), lane); continue; } r -= I_DN;
        if (r < I_DN) { transpose_item<0, false>(A.in[25] + (size_t)l * DFF * D, D, 0, nullptr, (bf16*)(ws + WS_W4 + l * SZ_W2), DFF, scr, r / (D / 64), r % (D / 64), lane); continue; } r -= I_DN;
        if (r < I_IN) { transpose_item<2, true>(A.in[8] + (size_t)l * D * 3088, 3088, 0, A.in[7] + l * D, (bf16*)(ws + WS_WIN + l * SZ_WIN), D, scr, r / (NIN / 64), r % (NIN / 64), lane); continue; } r -= I_IN;
        const int which = r / I_SQ, rr = r % I_SQ, kb = rr / (D / 64), nb = rr % (D / 64);
        if (which == 0) transpose_item<0, false>(A.in[17] + (size_t)l * D * D, D, 0, nullptr, (bf16*)(ws + WS_WOUT + l * SZ_SQ), D, scr, kb, nb, lane);
        else if (which == 1) transpose_item<0, true>(A.in[20] + (size_t)l * D * D, D, 0, A.in[18] + l * D, (bf16*)(ws + WS_WQ + l * SZ_SQ), D, scr, kb, nb, lane);
        else if (which == 2) transpose_item<0, false>(A.in[21] + (size_t)l * D * 2 * D, 2 * D, 0, nullptr, (bf16*)(ws + WS_WK + l * SZ_SQ), D, scr, kb, nb, lane);
        else if (which == 3) transpose_item<0, false>(A.in[21] + (size_t)l * D * 2 * D, 2 * D, D, nullptr, (bf16*)(ws + WS_WV + l * SZ_SQ), D, scr, kb, nb, lane);
        else transpose_item<0, false>(A.in[22] + (size_t)l * D * D, D, 0, nullptr, (bf16*)(ws + WS_WO + l * SZ_SQ), D, scr, kb, nb, lane);
    }
    u64* ssq0 = (u64*)(ws + WS_SSQ);
    for (int m = gw; m < M; m += 2 * NGW) {
        const int m2 = m + NGW;
        const f32x4* xr = (const f32x4*)(A.in[0] + (size_t)m * D) + lane; const f32x4* xr2 = (const f32x4*)(A.in[0] + (size_t)(m2 < M ? m2 : m) * D) + lane;
        f32x4 v[4], u[4];
#pragma unroll
        for (int j = 0; j < 4; ++j) { v[j] = xr[64 * j]; u[j] = xr2[64 * j]; }
        v2u* br = (v2u*)((bf16*)(ws + WS_XB) + (size_t)m * D) + lane; float ss = 0.f, ss2 = 0.f;
#pragma unroll
        for (int j = 0; j < 4; ++j) { v2u w; w.x = pg8::cvtpk_h(v[j][0], v[j][1]); w.y = pg8::cvtpk_h(v[j][2], v[j][3]); br[64 * j] = w; ss += (v[j][0] * v[j][0] + v[j][1] * v[j][1]) + (v[j][2] * v[j][2] + v[j][3] * v[j][3]); }
        ss = wave_sum(ss);
        if (lane == 0) ssq0[m] = (u64)(ss * pg8::SSQ_SCALE + 0.5f);
        if (m2 < M) { v2u* br2 = (v2u*)((bf16*)(ws + WS_XB) + (size_t)m2 * D) + lane;
#pragma unroll
            for (int j = 0; j < 4; ++j) { v2u w; w.x = pg8::cvtpk_h(u[j][0], u[j][1]); w.y = pg8::cvtpk_h(u[j][2], u[j][3]); br2[64 * j] = w; ss2 += (u[j][0] * u[j][0] + u[j][1] * u[j][1]) + (u[j][2] * u[j][2] + u[j][3] * u[j][3]); }
            ss2 = wave_sum(ss2);
            if (lane == 0) ssq0[m2] = (u64)(ss2 * pg8::SSQ_SCALE + 0.5f); }
    }
    for (int mm0 = gw; mm0 < DEPTH * MROWS; mm0 += 2 * NGW) {
        f32x4 v[2][4];
#pragma unroll
        for (int q = 0; q < 2; ++q) { const int mm = mm0 + q * NGW < DEPTH * MROWS ? mm0 + q * NGW : mm0; const f32x4* xr = (const f32x4*)(A.in[1] + (size_t)(mm % MROWS) * D) + lane;
#pragma unroll
            for (int j = 0; j < 4; ++j) v[q][j] = xr[64 * j]; }
#pragma unroll
        for (int q = 0; q < 2; ++q) { const int mm = mm0 + q * NGW; if (mm >= DEPTH * MROWS) break; const int l = mm / MROWS;
            const f32x4* gr = (const f32x4*)(A.in[19] + (size_t)l * D) + lane; v2u* br = (v2u*)((bf16*)(ws + WS_MEMN) + (size_t)mm * D) + lane; float ss = 0.f;
#pragma unroll
            for (int j = 0; j < 4; ++j) ss += (v[q][j][0] * v[q][j][0] + v[q][j][1] * v[q][j][1]) + (v[q][j][2] * v[q][j][2] + v[q][j][3] * v[q][j][3]);
            const float rs = 1.0f / sqrtf(wave_sum(ss) * (1.0f / D) + EPS);
#pragma unroll
            for (int j = 0; j < 4; ++j) { const f32x4 g = gr[64 * j]; v2u w; w.x = pk2(v[q][j][0] * rs * g[0], v[q][j][1] * rs * g[1]); w.y = pk2(v[q][j][2] * rs * g[2], v[q][j][3] * rs * g[3]); br[64 * j] = w; } }
    }
    for (int e = blockIdx.x * NTHR + tid; e < DEPTH * 256; e += G * NTHR) { const int ch = e & 255; const float a0 = A.in[3][ch], a1 = A.in[3][256 + ch]; const float mx = fmaxf(a0, a1);
        const float e0 = expf(a0 - mx), e1 = expf(a1 - mx); ((float*)(ws + WS_TAB_LB))[e] = (e < 256) ? 0.f : e1 / (e0 + e1); }
    for (int e = blockIdx.x * NTHR + tid; e < DEPTH * 128 * 16; e += G * NTHR) { const int l = e / 2048, ch = (e >> 4) & 127, r = e & 15; ((bf16*)(ws + WS_TAB_GW))[e] = (bf16)f2bf(A.in[10][(size_t)l * 2048 + r * 128 + ch]); }
    for (int e = blockIdx.x * NTHR + tid; e < DEPTH * 16 * D; e += G * NTHR) { const int l = e / (16 * D), r = (e / D) & 15, k = e % D;
        ((_Float16*)(ws + WS_WLR))[e] = (_Float16)(A.in[8][(size_t)l * D * 3088 + (size_t)k * 3088 + 1536 + r] * A.in[7][l * D + k]); }
    {
        float* cs = (float*)(ws + WS_ROPE); float* sn = cs + (size_t)M * 8; const int* pos = (const int*)A.in[2];
        for (int e = blockIdx.x * NTHR + tid; e < M * 8; e += G * NTHR) {
            const int row = e >> 3, i = e & 7;
            const float inv = powf(500000.0f, -(float)(2 * i) / 16.0f);
            const float ang = (float)pos[row] * inv; float s, c; sincosf(ang, &s, &c);
            cs[e] = c; sn[e] = s;
        }
    }
}

__device__ __forceinline__ void conv_unit(const Args& A, int l, int unit, LAS unsigned char* L) {
    int tid = threadIdx.x; asm volatile("" : "+v"(tid));
    const bf16* P = (const bf16*)(A.ws + WS_BIG); bf16* MIX = (bf16*)(A.ws + WS_MIX);
    LAS float* uu = (LAS float*)L;
    LAS float* yy = uu + 62 * 256;
    const int b = unit >> 6, t0 = (unit & 63) * 32; const size_t rowbase = (size_t)b * SEQ;
    v4u avr[4], gvr[4];
#pragma unroll
    for (int it = 0; it < 4; ++it) { const int e = tid + NTHR * it, i = e >> 5, c8 = (e & 31) * 8, t = t0 - 30 + i; avr[it] = (v4u){0u, 0u, 0u, 0u}; gvr[it] = avr[it];
        if (e < 62 * 32 && t >= 0) { avr[it] = *(const v4u*)(P + (rowbase + t) * NIN + C_CA + c8); gvr[it] = *(const v4u*)(P + (rowbase + t) * NIN + C_CG + c8); } }
#pragma unroll
    for (int it = 0; it < 4; ++it) { const int e = tid + NTHR * it; if (e >= 62 * 32) break; const int i = e >> 5, c8 = (e & 31) * 8; const int t = t0 - 30 + i;
        f32x4 u0 = (f32x4){0.f, 0.f, 0.f, 0.f}, u1 = u0;
        if (t >= 0) { const v4u av = avr[it], gv = gvr[it];
            const unsigned aw[4] = {av.x, av.y, av.z, av.w}, gw[4] = {gv.x, gv.y, gv.z, gv.w};
#pragma unroll
            for (int k = 0; k < 4; ++k) { const float a0 = bf2f((unsigned short)(aw[k] & 0xffff)), a1 = bf2f((unsigned short)(aw[k] >> 16)), g0 = bf2f((unsigned short)(gw[k] & 0xffff)), g1 = bf2f((unsigned short)(gw[k] >> 16));
                const float r0 = a0 * sigmoid_f(g0), r1 = a1 * sigmoid_f(g1);
                if (k < 2) { u0[2 * k] = r0; u0[2 * k + 1] = r1; } else { u1[2 * (k - 2)] = r0; u1[2 * (k - 2) + 1] = r1; } } }
        *(LAS f32x4*)(uu + i * 256 + c8) = u0; *(LAS f32x4*)(uu + i * 256 + c8 + 4) = u1; }
    const int c = tid & 255, th = tid >> 8;
    float w[31];
#pragma unroll
    for (int j = 0; j < 31; ++j) w[j] = A.in[13][(size_t)l * 31 * 256 + j * 256 + c];
    const float cb = A.in[14][l * 256 + c];
    __syncthreads();
#pragma unroll 1
    for (int g = 0; g < 4; ++g) { const int tb = 16 * th + 4 * g; const LAS float* up = uu + tb * 256 + c;
        float win[34];
#pragma unroll
        for (int i = 0; i < 34; ++i) win[i] = up[i * 256];
        float y0 = cb, y1 = cb, y2 = cb, y3 = cb;
#pragma unroll
        for (int j = 0; j < 31; ++j) { y0 += w[j] * win[j]; y1 += w[j] * win[j + 1]; y2 += w[j] * win[j + 2]; y3 += w[j] * win[j + 3]; }
        LAS float* yp = yy + tb * 256 + c; yp[0] = y0; yp[256] = y1; yp[512] = y2; yp[768] = y3; }
    __syncthreads();
    const int wave = tid >> 6, lane = tid & 63;
    const f32x4 g4 = *(const f32x4*)(A.in[15] + l * 256 + 4 * lane), b4 = *(const f32x4*)(A.in[16] + l * 256 + 4 * lane);
#pragma unroll
    for (int i = 0; i < 4; ++i) { const int t = wave * 4 + i; const f32x4 yv = *(const LAS f32x4*)(yy + t * 256 + 4 * lane);
        const float mu = wave_sum((yv[0] + yv[1]) + (yv[2] + yv[3])) * (1.0f / 256.0f); const f32x4 dv = yv - mu;
        const float var = wave_sum((dv[0] * dv[0] + dv[1] * dv[1]) + (dv[2] * dv[2] + dv[3] * dv[3])) * (1.0f / 256.0f); const float rs = 1.0f / sqrtf(var + EPS);
        const f32x4 yn = dv * rs * g4 + b4;
        v2u o; o.x = pk2(silu2(yn[0]), silu2(yn[1])); o.y = pk2(silu2(yn[2]), silu2(yn[3]));
        *(v2u*)(MIX + (rowbase + t0 + t) * D + 768 + 4 * lane) = o; }
    __syncthreads();
}

__device__ __forceinline__ float dbias(int d) {
    const unsigned ud = (unsigned)d; const int c = (int)(ud <= 128u) + (int)((ud <= 512u) & ((d & 3) == 0)) + (int)((d >= 0) & ((d & 15) == 0));
    return __builtin_amdgcn_logf((float)c);
}
__device__ __forceinline__ s16x4 vtr(const LAS unsigned char* p) { typedef short v4i16_t __attribute__((ext_vector_type(4))); return __builtin_bit_cast(s16x4, __builtin_amdgcn_ds_read_tr16_b64_v4i16((LAS v4i16_t*)p)); }
__device__ __forceinline__ float swapmax(float m) { return fmaxf(m, __shfl_xor(m, 32)); }
__device__ __forceinline__ float swapsum(float m) { return m + __shfl_xor(m, 32); }
constexpr size_t SCAN_U_HG = 0, SCAN_U_GL = (size_t)64 * 32 * 64 * 64 * 4, SCAN_D_HG = SCAN_U_GL + (size_t)64 * 32 * 64 * 32 * 4, SCAN_D_GL = SCAN_D_HG + (size_t)64 * 32 * 64 * 4;
constexpr size_t SCAN_S_OFF = 56 * MiB;
static_assert(SCAN_D_GL + (size_t)64 * 32 * 32 * 4 <= SCAN_S_OFF && SCAN_S_OFF + SCAN_D_HG <= (size_t)M * D * 4, "scan scratch fits d_out");

#define DPP_ADD(v, ctrl, rmask, bc) v += __builtin_bit_cast(float, __builtin_amdgcn_update_dpp(0, __builtin_bit_cast(int, v), ctrl, rmask, 0xF, bc))
__device__ __forceinline__ float scan32(float v) {
    DPP_ADD(v, 0x111, 0xF, true); DPP_ADD(v, 0x112, 0xF, true); DPP_ADD(v, 0x114, 0xF, true); DPP_ADD(v, 0x118, 0xF, true);
    DPP_ADD(v, 0x142, 0xA, false);
    return v;
}
__device__ __forceinline__ float bcast31(float v, int lane) { return __builtin_bit_cast(float, __builtin_amdgcn_ds_bpermute((31 + (lane & 32)) << 2, __builtin_bit_cast(int, v))); }
__device__ __forceinline__ float fexp2(float x) { return __builtin_amdgcn_exp2f(x); }
__device__ __forceinline__ float flog2(float x) { return __builtin_amdgcn_logf(x); }
__device__ __forceinline__ bf16x8 pack8(const float (&x)[8]) { v4u w = (v4u){pg8::cvtpk(x[0], x[1]), pg8::cvtpk(x[2], x[3]), pg8::cvtpk(x[4], x[5]), pg8::cvtpk(x[6], x[7])}; return __builtin_bit_cast(bf16x8, w); }
struct Raw8 { v2u a, b; };
__device__ __forceinline__ Raw8 ldraw(const bf16* rowp, int s, int hi) { Raw8 r; r.a = *(const v2u*)(rowp + 16 * s + 4 * hi); r.b = *(const v2u*)(rowp + 16 * s + 8 + 4 * hi); return r; }
__device__ __forceinline__ void unpack8(const Raw8& r, float (&x)[8]) {
    x[0] = bf2f((unsigned short)(r.a.x & 0xffff)); x[1] = bf2f((unsigned short)(r.a.x >> 16)); x[2] = bf2f((unsigned short)(r.a.y & 0xffff)); x[3] = bf2f((unsigned short)(r.a.y >> 16));
    x[4] = bf2f((unsigned short)(r.b.x & 0xffff)); x[5] = bf2f((unsigned short)(r.b.x >> 16)); x[6] = bf2f((unsigned short)(r.b.y & 0xffff)); x[7] = bf2f((unsigned short)(r.b.y >> 16));
}
__device__ __forceinline__ void ld8(const bf16* rowp, int s, int hi, float (&x)[8]) {
    const v2u a = *(const v2u*)(rowp + 16 * s + 4 * hi), b = *(const v2u*)(rowp + 16 * s + 8 + 4 * hi);
    x[0] = bf2f((unsigned short)(a.x & 0xffff)); x[1] = bf2f((unsigned short)(a.x >> 16)); x[2] = bf2f((unsigned short)(a.y & 0xffff)); x[3] = bf2f((unsigned short)(a.y >> 16));
    x[4] = bf2f((unsigned short)(b.x & 0xffff)); x[5] = bf2f((unsigned short)(b.x >> 16)); x[6] = bf2f((unsigned short)(b.y & 0xffff)); x[7] = bf2f((unsigned short)(b.y >> 16));
}
__device__ __forceinline__ int img_off(int row, int col) { return (((col >> 5) * 4 + (row >> 4)) << 10) + ((row & 15) << 6) + ((col & 31) << 1); }
__device__ __forceinline__ bf16x8 tr_frag(const LAS unsigned char* img, int colhalf, int rowgroup, int lane) {
    const LAS unsigned char* p = img + ((colhalf * 4 + rowgroup) << 10) + ((lane >> 4) & 1) * 32 + (lane & 3) * 8 + (4 * (lane >> 5) + ((lane & 15) >> 2)) * 64;
    const s16x4 a = vtr(p), b = vtr(p + 512);
    return (bf16x8){a[0], a[1], a[2], a[3], b[0], b[1], b[2], b[3]};
}
template <int DK, bool HG>
__device__ __forceinline__ void scan_gates(const Raw8& zk, const f32x4& c0, const f32x4& c1, int s, const f32x16& acc, float (&lg2)[8], float (&kv)[8]) {
    float z[8]; unpack8(zk, z);
    if (HG) {
#pragma unroll
        for (int j = 0; j < 8; ++j) { const float lb = j < 4 ? c0[j & 3] : c1[j & 3]; const float e = fexp2(-LOG2E * fmaxf(z[j], -80.f)); const float sg = __builtin_amdgcn_rcpf(1.0f + e);
            const float f = lb + (1.0f - lb) * sg; lg2[j] = flog2(fmaxf(f, 1e-30f)); kv[j] = (1.0f - lb) * (e * sg); }
    } else {
#pragma unroll
        for (int j = 0; j < 8; ++j) { const float lo = acc[8 * s + j] + (j < 4 ? c0[j & 3] : c1[j & 3]); const float e = fexp2(-LOG2E * fmaxf(lo, -80.f));
            lg2[j] = -flog2(1.0f + e) * (1.0f / 16.0f); kv[j] = z[j]; }
    }
}
__device__ __forceinline__ bf16x8 gla_gw(const Args& A, int l, int h, int hi, int lane) {
    return *(const bf16x8*)((const bf16*)(A.ws + WS_TAB_GW) + (size_t)l * 128 * 16 + (h * 32 + (lane & 31)) * 16 + 8 * hi); }
__device__ __forceinline__ f32x16 gla_logits(const bf16x8& af, const bf16x8& lrf) {
    f32x16 acc;
#pragma unroll
    for (int r = 0; r < 16; ++r) acc[r] = 0.f;
    return __builtin_amdgcn_mfma_f32_32x32x16_bf16(af, lrf, acc, 0, 0, 0);
}
template <bool HG> __device__ __forceinline__ const float* scan_cptr(const Args& A, int l, int h) { return HG ? ((const float*)(A.ws + WS_TAB_LB) + l * 256 + h * 64) : (A.in[11] + l * 128 + h * 32); }

template <int DK, bool HG>
__device__ __forceinline__ void scan_taskA(const Args& A, int l, int seq, int chunk, LAS unsigned char* WL) {
    constexpr int KS = DK / 16, CB = DK / 32;
    int lane = threadIdx.x & 63; asm volatile("" : "+v"(lane));
    const int r32 = lane & 31, hi = lane >> 5, b = seq >> 2, h = seq & 3;
    const bf16* P = (const bf16*)(A.ws + WS_BIG);
    const size_t row0 = (size_t)b * SEQ + chunk * 64;
    LAS unsigned char* kimg = WL; LAS unsigned char* vimg = WL + 8192;
    const int cv = HG ? (C_HI + h * 64) : (C_GV + h * 64), czk = HG ? (C_HF + h * 64) : (C_GK + h * 32);
    const bf16* rp0 = P + (row0 + r32) * NIN; const bf16* rp1 = P + (row0 + 32 + r32) * NIN;
    v4u vraw[8];
#pragma unroll
    for (int w = 0; w < 8; ++w) vraw[w] = *(const v4u*)(P + (row0 + 16 * (w & 3) + (lane >> 2)) * NIN + cv + (w >> 2) * 32 + (lane & 3) * 8);
    Raw8 zk[2][KS]; f32x4 cc[KS][2]; const float* cp = scan_cptr<HG>(A, l, h);
#pragma unroll
    for (int s = 0; s < KS; ++s) { zk[0][s] = ldraw(rp0 + czk, s, hi); zk[1][s] = ldraw(rp1 + czk, s, hi); cc[s][0] = *(const f32x4*)(cp + 16 * s + 4 * hi); cc[s][1] = *(const f32x4*)(cp + 16 * s + 8 + 4 * hi); }
    f32x16 lg0, lg1;
#pragma unroll
    for (int r = 0; r < 16; ++r) { lg0[r] = 0.f; lg1[r] = 0.f; }
    if (!HG) { const bf16x8 af = gla_gw(A, l, h, hi, lane), l0 = *(const bf16x8*)((const bf16*)(A.ws + WS_LR) + (row0 + r32) * 16 + 8 * hi), l1 = *(const bf16x8*)((const bf16*)(A.ws + WS_LR) + (row0 + 32 + r32) * 16 + 8 * hi); lg0 = gla_logits(af, l0); lg1 = gla_logits(af, l1); }
#pragma unroll
    for (int w = 0; w < 8; ++w) *(LAS v4u*)(vimg + w * 1024 + lane * 16) = vraw[w];
    __builtin_amdgcn_s_barrier();
    float* dv = (float*)((unsigned char*)A.out + (HG ? SCAN_D_HG : SCAN_D_GL)) + ((size_t)(seq & 63) * 32 + chunk) * DK;
#pragma unroll
    for (int s = 0; s < KS; ++s) { float b0[8], b1[8], k0[8], k1[8];
        scan_gates<DK, HG>(zk[0][s], cc[s][0], cc[s][1], s, lg0, b0, k0); scan_gates<DK, HG>(zk[1][s], cc[s][0], cc[s][1], s, lg1, b1, k1);
#pragma unroll
        for (int j = 0; j < 8; ++j) { b0[j] = scan32(b0[j]); b1[j] = scan32(b1[j]); }
        float ed[8];
#pragma unroll
        for (int j = 0; j < 8; ++j) { const float t0 = bcast31(b0[j], lane); b1[j] += t0; const float bl = bcast31(b1[j], lane);
            k0[j] *= fexp2(bl - b0[j]); k1[j] *= fexp2(bl - b1[j]); ed[j] = fexp2(bl); }
        if (r32 == 31) { *(f32x4*)(dv + 16 * s + 4 * hi) = (f32x4){ed[0], ed[1], ed[2], ed[3]}; *(f32x4*)(dv + 16 * s + 8 + 4 * hi) = (f32x4){ed[4], ed[5], ed[6], ed[7]}; }
        const int c0 = 16 * s + 4 * hi;
        *(LAS v2u*)(kimg + img_off(r32, c0)) = (v2u){pg8::cvtpk(k0[0], k0[1]), pg8::cvtpk(k0[2], k0[3])}; *(LAS v2u*)(kimg + img_off(r32, c0 + 8)) = (v2u){pg8::cvtpk(k0[4], k0[5]), pg8::cvtpk(k0[6], k0[7])};
        *(LAS v2u*)(kimg + img_off(32 + r32, c0)) = (v2u){pg8::cvtpk(k1[0], k1[1]), pg8::cvtpk(k1[2], k1[3])}; *(LAS v2u*)(kimg + img_off(32 + r32, c0 + 8)) = (v2u){pg8::cvtpk(k1[4], k1[5]), pg8::cvtpk(k1[6], k1[7])}; }
    asm volatile("s_waitcnt lgkmcnt(0)" ::: "memory");
    __builtin_amdgcn_s_barrier();
    float* UT = (float*)((unsigned char*)A.out + (HG ? SCAN_U_HG : SCAN_U_GL)) + ((size_t)(seq & 63) * 32 + chunk) * 64 * DK;
#pragma unroll
    for (int vb = 0; vb < 2; ++vb)
#pragma unroll
        for (int cb = 0; cb < CB; ++cb) { f32x16 acc;
#pragma unroll
            for (int r = 0; r < 16; ++r) acc[r] = 0.f;
#pragma unroll
            for (int tg = 0; tg < 4; ++tg) acc = __builtin_amdgcn_mfma_f32_32x32x16_bf16(tr_frag(kimg, cb, tg, lane), tr_frag(vimg, vb, tg, lane), acc, 0, 0, 0);
#pragma unroll
            for (int g = 0; g < 4; ++g) *(f32x4*)(UT + (size_t)(32 * vb + r32) * DK + 32 * cb + 8 * g + 4 * hi) = (f32x4){acc[4 * g], acc[4 * g + 1], acc[4 * g + 2], acc[4 * g + 3]}; }
}

__device__ __forceinline__ void scan_phaseB(const Args& A, int G) {
    const int nit = G == 256 ? 1 : (192 + G - 1) / G;
    for (int it = 0; it < nit; ++it) {
        int E; if (G == 256) { if (threadIdx.x >= 384) break; E = blockIdx.x * 384 + threadIdx.x; } else { const int w = blockIdx.x + it * G; if (w >= 192) break; E = w * NTHR + threadIdx.x; }
        const bool hg = E < 65536; const int DKc = hg ? 64 : 32; const int e = hg ? E : E - 65536;
        const int per = 64 * DKc / 4, seq = e / per, rem = e % per, v = rem / (DKc / 4), c4 = rem % (DKc / 4);
        float* U = (float*)((unsigned char*)A.out + (hg ? SCAN_U_HG : SCAN_U_GL)) + (size_t)seq * 32 * 64 * DKc + (size_t)v * DKc + 4 * c4;
        const float* dv = (const float*)((unsigned char*)A.out + (hg ? SCAN_D_HG : SCAN_D_GL)) + (size_t)seq * 32 * DKc + 4 * c4;
        f32x4 S = (f32x4){0.f, 0.f, 0.f, 0.f};
#pragma unroll 1
        for (int c0 = 0; c0 < 32; c0 += 16) { f32x4 u[16], d[16];
#pragma unroll
            for (int i = 0; i < 16; ++i) { u[i] = *(const f32x4*)(U + (size_t)(c0 + i) * 64 * DKc); d[i] = *(const f32x4*)(dv + (size_t)(c0 + i) * DKc); }
#pragma unroll
            for (int i = 0; i < 16; ++i) { *(f32x4*)((unsigned char*)(U + (size_t)(c0 + i) * 64 * DKc) + SCAN_S_OFF) = S; S = d[i] * S + u[i]; } }
    }
}

template <int DK, bool HG>
__device__ __forceinline__ void scan_taskC(const Args& A, int l, int seq, int chunk, LAS unsigned char* WL) {
    constexpr int KS = DK / 16;
    int lane = threadIdx.x & 63; asm volatile("" : "+v"(lane));
    const int r32 = lane & 31, hi = lane >> 5, b = seq >> 2, h = seq & 3;
    const bf16* P = (const bf16*)(A.ws + WS_BIG); bf16* MIX = (bf16*)(A.ws + WS_MIX);
    const size_t row0 = (size_t)b * SEQ + chunk * 64;
    LAS unsigned char* vimg = WL;
    const int cq = HG ? (C_HQ + h * 64) : (C_GQ + h * 32), cv = HG ? (C_HI + h * 64) : (C_GV + h * 64), cg = HG ? (C_HG + h * 64) : (C_GR + h * 64);
    const int czk = HG ? (C_HF + h * 64) : (C_GK + h * 32);
    const bf16* rp0 = P + (row0 + r32) * NIN; const bf16* rp1 = P + (row0 + 32 + r32) * NIN;
    v4u vraw[8];
#pragma unroll
    for (int w = 0; w < 8; ++w) vraw[w] = *(const v4u*)(P + (row0 + 16 * (w & 3) + (lane >> 2)) * NIN + cv + (w >> 2) * 32 + (lane & 3) * 8);
    Raw8 zk[2][KS], qq[2][KS]; f32x4 cc[KS][2]; const float* cp = scan_cptr<HG>(A, l, h);
#pragma unroll
    for (int s = 0; s < KS; ++s) { zk[0][s] = ldraw(rp0 + czk, s, hi); zk[1][s] = ldraw(rp1 + czk, s, hi); qq[0][s] = ldraw(rp0 + cq, s, hi); qq[1][s] = ldraw(rp1 + cq, s, hi);
        cc[s][0] = *(const f32x4*)(cp + 16 * s + 4 * hi); cc[s][1] = *(const f32x4*)(cp + 16 * s + 8 + 4 * hi); }
    f32x16 lg0, lg1;
#pragma unroll
    for (int r = 0; r < 16; ++r) { lg0[r] = 0.f; lg1[r] = 0.f; }
    if (!HG) { const bf16x8 af = gla_gw(A, l, h, hi, lane), l0 = *(const bf16x8*)((const bf16*)(A.ws + WS_LR) + (row0 + r32) * 16 + 8 * hi), l1 = *(const bf16x8*)((const bf16*)(A.ws + WS_LR) + (row0 + 32 + r32) * 16 + 8 * hi); lg0 = gla_logits(af, l0); lg1 = gla_logits(af, l1); }
#pragma unroll
    for (int w = 0; w < 8; ++w) *(LAS v4u*)(vimg + w * 1024 + lane * 16) = vraw[w];
    __builtin_amdgcn_s_barrier();
    const float qsc = HG ? 1.0f : 0.17677669529663687f;
    bf16x8 qh[2][KS], qt1[KS], k0[KS], k1[2][KS];
    {
#pragma unroll
        for (int s = 0; s < KS; ++s) { float b0[8], b1[8], kk0[8], kk1[8], q0[8], q1[8], x[8], B1[8];
            scan_gates<DK, HG>(zk[0][s], cc[s][0], cc[s][1], s, lg0, b0, kk0); scan_gates<DK, HG>(zk[1][s], cc[s][0], cc[s][1], s, lg1, b1, kk1);
            unpack8(qq[0][s], q0); unpack8(qq[1][s], q1);
#pragma unroll
            for (int j = 0; j < 8; ++j) { b0[j] = scan32(b0[j]); b1[j] = scan32(b1[j]); }
#pragma unroll
            for (int j = 0; j < 8; ++j) B1[j] = bcast31(b0[j], lane);
#pragma unroll
            for (int j = 0; j < 8; ++j) x[j] = q0[j] * qsc * fexp2(b0[j]);
            qh[0][s] = pack8(x);
#pragma unroll
            for (int j = 0; j < 8; ++j) x[j] = q1[j] * qsc * fexp2(b1[j]);
            qh[1][s] = pack8(x);
#pragma unroll
            for (int j = 0; j < 8; ++j) x[j] = q1[j] * qsc * fexp2(b1[j] + B1[j]);
            qt1[s] = pack8(x);
#pragma unroll
            for (int j = 0; j < 8; ++j) x[j] = kk0[j] * fexp2(fminf(-b0[j], 120.f));
            k0[s] = pack8(x);
#pragma unroll
            for (int j = 0; j < 8; ++j) x[j] = kk0[j] * fexp2(B1[j] - b0[j]);
            k1[0][s] = pack8(x);
#pragma unroll
            for (int j = 0; j < 8; ++j) x[j] = kk1[j] * fexp2(fminf(-b1[j], 120.f));
            k1[1][s] = pack8(x); }
    }
    __builtin_amdgcn_s_barrier();
    const float* ST = (const float*)((unsigned char*)A.out + SCAN_S_OFF + (HG ? SCAN_U_HG : SCAN_U_GL)) + ((size_t)(seq & 63) * 32 + chunk) * 64 * DK;
    f32x4 st[2][KS][2];
#pragma unroll
    for (int s = 0; s < KS; ++s) { const float* sp = ST + (size_t)r32 * DK + 16 * s + 4 * hi; st[0][s][0] = *(const f32x4*)sp; st[0][s][1] = *(const f32x4*)(sp + 8); }
    asm volatile("s_waitcnt lgkmcnt(0)" ::: "memory");
    f32x16 x00, x01, x11;
#pragma unroll
    for (int r = 0; r < 16; ++r) { x00[r] = 0.f; x01[r] = 0.f; x11[r] = 0.f; }
#pragma unroll
    for (int s = 0; s < KS; ++s) { x00 = __builtin_amdgcn_mfma_f32_32x32x16_bf16(k0[s], qh[0][s], x00, 0, 0, 0); x01 = __builtin_amdgcn_mfma_f32_32x32x16_bf16(k1[0][s], qh[1][s], x01, 0, 0, 0);
        x11 = __builtin_amdgcn_mfma_f32_32x32x16_bf16(k1[1][s], qh[1][s], x11, 0, 0, 0); }
    __builtin_amdgcn_s_barrier();
    asm volatile("" ::: "memory");
#pragma unroll
    for (int s = 0; s < KS; ++s) { const float* sp = ST + (size_t)(32 + r32) * DK + 16 * s + 4 * hi; st[1][s][0] = *(const f32x4*)sp; st[1][s][1] = *(const f32x4*)(sp + 8); }
    const float* og = (HG ? A.in[9] : A.in[12]) + l * 256 + h * 64;
    v2u graw[2][2][4];
#pragma unroll
    for (int vb = 0; vb < 2; ++vb)
#pragma unroll
        for (int g = 0; g < 4; ++g) { const int v0 = 32 * vb + 8 * g + 4 * hi; graw[0][vb][g] = *(const v2u*)(rp0 + cg + v0); graw[1][vb][g] = *(const v2u*)(rp1 + cg + v0); }
#pragma unroll
    for (int r = 0; r < 16; ++r) { const bool keep = crow(r, hi) <= r32; x00[r] = keep ? x00[r] : 0.f; x11[r] = keep ? x11[r] : 0.f; }
    bf16x8 p00[2], p01[2], p11[2];
#pragma unroll
    for (int k = 0; k < 2; ++k) { float t0[8], t1[8], t2[8];
#pragma unroll
        for (int j = 0; j < 8; ++j) { t0[j] = x00[8 * k + j]; t1[j] = x01[8 * k + j]; t2[j] = x11[8 * k + j]; }
        p00[k] = pack8(t0); p01[k] = pack8(t1); p11[k] = pack8(t2); }
    f32x16 o[2][2];
#pragma unroll
    for (int vb = 0; vb < 2; ++vb) {
#pragma unroll
        for (int r = 0; r < 16; ++r) { o[vb][0][r] = 0.f; o[vb][1][r] = 0.f; }
#pragma unroll
        for (int k = 0; k < 2; ++k) { const bf16x8 v0 = tr_frag(vimg, vb, k, lane), v1 = tr_frag(vimg, vb, 2 + k, lane);
            o[vb][0] = __builtin_amdgcn_mfma_f32_32x32x16_bf16(v0, p00[k], o[vb][0], 0, 0, 0);
            o[vb][1] = __builtin_amdgcn_mfma_f32_32x32x16_bf16(v0, p01[k], o[vb][1], 0, 0, 0);
            o[vb][1] = __builtin_amdgcn_mfma_f32_32x32x16_bf16(v1, p11[k], o[vb][1], 0, 0, 0); }
#pragma unroll
        for (int s = 0; s < KS; ++s) { const f32x4 a = st[vb][s][0], c = st[vb][s][1];
            const float sx[8] = {a[0], a[1], a[2], a[3], c[0], c[1], c[2], c[3]}; const bf16x8 sf = pack8(sx);
            o[vb][0] = __builtin_amdgcn_mfma_f32_32x32x16_bf16(sf, qh[0][s], o[vb][0], 0, 0, 0);
            o[vb][1] = __builtin_amdgcn_mfma_f32_32x32x16_bf16(sf, qt1[s], o[vb][1], 0, 0, 0); }
    }
    __builtin_amdgcn_s_barrier();
    f32x4 gn[2][4];
#pragma unroll
    for (int vb = 0; vb < 2; ++vb)
#pragma unroll
        for (int g = 0; g < 4; ++g) gn[vb][g] = *(const f32x4*)(og + 32 * vb + 8 * g + 4 * hi);
#pragma unroll
    for (int tb = 0; tb < 2; ++tb) { float ss = 0.f;
#pragma unroll
        for (int vb = 0; vb < 2; ++vb)
#pragma unroll
            for (int r = 0; r < 16; ++r) ss += o[vb][tb][r] * o[vb][tb][r];
        ss += __shfl_xor(ss, 32);
        const float rs = 1.0f / sqrtf(ss * (1.0f / 64.0f) + EPS);
        bf16* orow = MIX + (row0 + 32 * tb + r32) * D + (HG ? 0 : 256) + h * 64;
#pragma unroll
        for (int vb = 0; vb < 2; ++vb)
#pragma unroll
            for (int g = 0; g < 4; ++g) { const int v0 = 32 * vb + 8 * g + 4 * hi; const v2u gg = graw[tb][vb][g]; const f32x4 gnv = gn[vb][g];
                const float g0 = bf2f((unsigned short)(gg.x & 0xffff)), g1 = bf2f((unsigned short)(gg.x >> 16)), g2 = bf2f((unsigned short)(gg.y & 0xffff)), g3 = bf2f((unsigned short)(gg.y >> 16));
                v2u w; w.x = pk2(o[vb][tb][4 * g] * rs * gnv[0] * silu2(g0), o[vb][tb][4 * g + 1] * rs * gnv[1] * silu2(g1)); w.y = pk2(o[vb][tb][4 * g + 2] * rs * gnv[2] * silu2(g2), o[vb][tb][4 * g + 3] * rs * gnv[3] * silu2(g3));
                *(v2u*)(orow + v0) = w; } }
}

__device__ __forceinline__ void dattn_unit(const Args& A, int unit, LAS unsigned char* L) {
    int tid = threadIdx.x; asm volatile("" : "+v"(tid));
    const bf16* P = (const bf16*)(A.ws + WS_BIG); bf16* MIX = (bf16*)(A.ws + WS_MIX);
    const int lane = tid & 63, r32 = lane & 31, hi = lane >> 5, wid = __builtin_amdgcn_readfirstlane(tid >> 6);
    const int bh = unit >> 3, qb = unit & 7, b = bh >> 2, h = bh & 3; const size_t rowbase = (size_t)b * SEQ; const int q0 = qb * 256;
    const int qw = q0 + wid * 32, qpos = qw + r32;
    const bf16* Qp = P + (rowbase + qpos) * NIN + C_DQ + h * 64;
    bf16x8 qr[4];
#pragma unroll
    for (int d0 = 0; d0 < 4; ++d0) qr[d0] = *(const bf16x8*)(Qp + d0 * 16 + hi * 8);
    const int srow = (tid >> 6) * 8 + (tid & 7), spc = (tid >> 3) & 7;
    const bf16* ksrc = P + (rowbase + srow) * NIN + C_DK + h * 64 + spc * 8;
    const bf16* vsrc = P + (rowbase + srow) * NIN + C_DV + h * 64 + spc * 8;
    const int kdst = spc * 1024 + srow * 16, vdst = 8192 + (((spc >> 2) * 4 + (srow >> 4)) << 10) + ((srow & 15) << 6) + ((spc & 3) << 4);
    const int NT = (q0 + 256) / 64;
    v4u kreg = *(const v4u*)ksrc, vreg = *(const v4u*)vsrc;
    float bfar[16], bmid[16], bnear[16];
#pragma unroll
    for (int r = 0; r < 16; ++r) { const int dm = (qpos - crow(r, hi)) & 15; bfar[r] = dm == 0 ? 0.f : -INFINITY; bmid[r] = dm == 0 ? 1.0f : ((dm & 3) == 0 ? 0.f : -INFINITY);
        bnear[r] = dm == 0 ? 1.5849625007211562f : ((dm & 3) == 0 ? 1.0f : 0.f); }
#define DA_STRADDLE(T_, LO_, HI_) { const int x = qpos - 64 * t - 4 * hi - (T_); \
        _Pragma("unroll") for (int r = 0; r < 16; ++r) { const int off = (r & 3) + 8 * (r >> 2); p0[r] += (x <= off) ? (LO_) : (HI_); p1[r] += (x <= off + 32) ? (LO_) : (HI_); rm = fmaxf(rm, fmaxf(p0[r], p1[r])); } }
    float mrun = -1e30f, lsum = 0.f; f32x16 o0, o1;
#pragma unroll
    for (int r = 0; r < 16; ++r) { o0[r] = 0.f; o1[r] = 0.f; }
    for (int t = 0; t < NT; ++t) {
        LAS unsigned char* buf = L + (t & 1) * 16384;
        *(LAS v4u*)(buf + kdst) = kreg; *(LAS v4u*)(buf + vdst) = vreg;
        if (t + 1 < NT) { kreg = *(const v4u*)(ksrc + (size_t)(t + 1) * 64 * NIN); vreg = *(const v4u*)(vsrc + (size_t)(t + 1) * 64 * NIN); }
        __syncthreads();
        if (64 * t <= qw + 31) {
            const LAS unsigned char* kb = buf + hi * 1024 + r32 * 16;
            f32x16 p0, p1;
#pragma unroll
            for (int r = 0; r < 16; ++r) { p0[r] = 0.f; p1[r] = 0.f; }
#pragma unroll
            for (int d0 = 0; d0 < 4; ++d0) { const bf16x8 b0 = *(const LAS bf16x8*)(kb + d0 * 2048), b1 = *(const LAS bf16x8*)(kb + d0 * 2048 + 512);
                p0 = __builtin_amdgcn_mfma_f32_32x32x16_bf16(b0, qr[d0], p0, 0, 0, 0); p1 = __builtin_amdgcn_mfma_f32_32x32x16_bf16(b1, qr[d0], p1, 0, 0, 0); }
            const int dmin = qw - 64 * t - 63, dmax = qw + 31 - 64 * t;
            float rm = -INFINITY;
            if (dmin > 512) {
#pragma unroll
                for (int r = 0; r < 16; ++r) { p0[r] += bfar[r]; p1[r] += bfar[r]; rm = fmaxf(rm, fmaxf(p0[r], p1[r])); }
            } else if (dmin > 128 && dmax <= 512) {
#pragma unroll
                for (int r = 0; r < 16; ++r) { p0[r] += bmid[r]; p1[r] += bmid[r]; rm = fmaxf(rm, fmaxf(p0[r], p1[r])); }
            } else if (dmin >= 0 && dmax <= 128) {
#pragma unroll
                for (int r = 0; r < 16; ++r) { p0[r] += bnear[r]; p1[r] += bnear[r]; rm = fmaxf(rm, fmaxf(p0[r], p1[r])); }
            } else if (dmin < 0) DA_STRADDLE(-1, -INFINITY, bnear[r])
            else if (dmin <= 128) DA_STRADDLE(128, bnear[r], bmid[r])
            else DA_STRADDLE(512, bmid[r], bfar[r])
            rm = swapmax(rm);
            const float mnew = fmaxf(mrun, rm);
            if (!__all(mnew == mrun)) {
                const float alpha = __builtin_amdgcn_exp2f(mrun - mnew); mrun = mnew; lsum *= alpha;
#pragma unroll
                for (int r = 0; r < 16; ++r) { o0[r] *= alpha; o1[r] *= alpha; } }
            float rs = 0.f;
#pragma unroll
            for (int r = 0; r < 16; ++r) { p0[r] = __builtin_amdgcn_exp2f(p0[r] - mrun); p1[r] = __builtin_amdgcn_exp2f(p1[r] - mrun); rs += p0[r] + p1[r]; }
            lsum += rs;
            v4u pw[4];
#pragma unroll
            for (int k = 0; k < 2; ++k) {
                pw[k] = (v4u){pg8::cvtpk(p0[8 * k], p0[8 * k + 1]), pg8::cvtpk(p0[8 * k + 2], p0[8 * k + 3]), pg8::cvtpk(p0[8 * k + 4], p0[8 * k + 5]), pg8::cvtpk(p0[8 * k + 6], p0[8 * k + 7])};
                pw[2 + k] = (v4u){pg8::cvtpk(p1[8 * k], p1[8 * k + 1]), pg8::cvtpk(p1[8 * k + 2], p1[8 * k + 3]), pg8::cvtpk(p1[8 * k + 4], p1[8 * k + 5]), pg8::cvtpk(p1[8 * k + 6], p1[8 * k + 7])}; }
            const LAS unsigned char* vb = buf + 8192 + ((lane >> 4) & 1) * 32 + (lane & 3) * 8 + (4 * hi + ((lane & 15) >> 2)) * 64;
#pragma unroll
            for (int ks = 0; ks < 4; ++ks) {
                const s16x4 a0 = vtr(vb + ks * 1024), a1 = vtr(vb + ks * 1024 + 512), c0 = vtr(vb + 4096 + ks * 1024), c1 = vtr(vb + 4096 + ks * 1024 + 512);
                const bf16x8 va = (bf16x8){a0[0], a0[1], a0[2], a0[3], a1[0], a1[1], a1[2], a1[3]}, vc = (bf16x8){c0[0], c0[1], c0[2], c0[3], c1[0], c1[1], c1[2], c1[3]};
                const bf16x8 pf = __builtin_bit_cast(bf16x8, pw[ks]);
                o0 = __builtin_amdgcn_mfma_f32_32x32x16_bf16(va, pf, o0, 0, 0, 0); o1 = __builtin_amdgcn_mfma_f32_32x32x16_bf16(vc, pf, o1, 0, 0, 0); }
        }
    }
    const float linv = 1.0f / swapsum(lsum);
    bf16* orow = MIX + (rowbase + qpos) * D + 512 + h * 64;
#pragma unroll
    for (int g = 0; g < 4; ++g) { v2u w0, w1;
        w0.x = pk2(o0[4 * g] * linv, o0[4 * g + 1] * linv); w0.y = pk2(o0[4 * g + 2] * linv, o0[4 * g + 3] * linv);
        w1.x = pk2(o1[4 * g] * linv, o1[4 * g + 1] * linv); w1.y = pk2(o1[4 * g + 2] * linv, o1[4 * g + 3] * linv);
        *(v2u*)(orow + 8 * g + 4 * hi) = w0; *(v2u*)(orow + 32 + 8 * g + 4 * hi) = w1; }
    __syncthreads();
}

__device__ __forceinline__ void xattn_unit(const Args& A, int l, int unit, LAS unsigned char* L) {
    int tid = threadIdx.x; asm volatile("" : "+v"(tid));
    const bf16* Q = (const bf16*)(A.ws + WS_BIG); bf16* AO = (bf16*)(A.ws + WS_BIG + 64 * MiB);
    const bf16* Kb = (const bf16*)(A.ws + WS_KB) + (size_t)l * MROWS * D; const bf16* Vt = (const bf16*)(A.ws + WS_VT) + (size_t)l * D * MROWS;
    const int lane = tid & 63, r32 = lane & 31, hi = lane >> 5, wid = __builtin_amdgcn_readfirstlane(tid >> 6);
    const int bh = unit >> 3, qb = unit & 7, b = bh >> 2, h = bh & 3;
    const size_t qrow = (size_t)b * SEQ + qb * 256 + wid * 32 + r32;
    bf16x8 qf[16];
    {   v4u kr[16];
#pragma unroll
        for (int i = 0; i < 16; ++i) { const int e = tid + NTHR * i, key = e >> 5, ch = e & 31; kr[i] = *(const v4u*)(Kb + (size_t)(b * MEMLEN + key) * D + h * 256 + ch * 8); }
#pragma unroll
        for (int s = 0; s < 16; ++s) qf[s] = *(const bf16x8*)(Q + qrow * D + h * 256 + 16 * s + 8 * hi);
#pragma unroll
        for (int i = 0; i < 16; ++i) { const int e = tid + NTHR * i, key = e >> 5, ch = e & 31; *(LAS v4u*)(L + key * 528 + (ch << 4)) = kr[i]; } }
    __syncthreads();
    v4u pf[16]; float mh[2], lh[2];
    const LAS unsigned char* kbase = L + r32 * 528 + (hi << 4);
#pragma unroll
    for (int half = 0; half < 2; ++half) {
        f32x16 sc[4];
#pragma unroll
        for (int kt = 0; kt < 4; ++kt)
#pragma unroll
            for (int r = 0; r < 16; ++r) sc[kt][r] = 0.f;
        {   const LAS unsigned char* kh = kbase + (32 * 4 * half) * 528;
            bf16x8 cur[4], nxt[4];
#pragma unroll
            for (int j = 0; j < 4; ++j) cur[j] = *(const LAS bf16x8*)(kh + ((2 * j) << 4));
            __builtin_amdgcn_sched_barrier(0);
#pragma unroll
            for (int t = 0; t < 16; ++t) { const int sg = t >> 2, kt = t & 3;
                if (t < 15) { const int sg1 = (t + 1) >> 2, kt1 = (t + 1) & 3;
#pragma unroll
                    for (int j = 0; j < 4; ++j) nxt[j] = *(const LAS bf16x8*)(kh + (32 * kt1) * 528 + ((2 * (4 * sg1 + j)) << 4)); }
                __builtin_amdgcn_sched_barrier(0);
#pragma unroll
                for (int j = 0; j < 4; ++j) sc[kt] = __builtin_amdgcn_mfma_f32_32x32x16_bf16(cur[j], qf[4 * sg + j], sc[kt], 0, 0, 0);
                __builtin_amdgcn_sched_barrier(0);
                if (t < 15) {
#pragma unroll
                    for (int j = 0; j < 4; ++j) cur[j] = nxt[j]; } } }
        float rm = -INFINITY;
#pragma unroll
        for (int kt = 0; kt < 4; ++kt)
#pragma unroll
            for (int r = 0; r < 16; ++r) rm = fmaxf(rm, sc[kt][r]);
        rm = swapmax(rm); mh[half] = rm;
        float ls = 0.f;
#pragma unroll
        for (int kt = 0; kt < 4; ++kt) {
#pragma unroll
            for (int r = 0; r < 16; ++r) { sc[kt][r] = __builtin_amdgcn_exp2f(sc[kt][r] - rm); ls += sc[kt][r]; }
#pragma unroll
            for (int k = 0; k < 2; ++k) pf[8 * half + 2 * kt + k] = (v4u){pg8::cvtpk(sc[kt][8 * k], sc[kt][8 * k + 1]), pg8::cvtpk(sc[kt][8 * k + 2], sc[kt][8 * k + 3]), pg8::cvtpk(sc[kt][8 * k + 4], sc[kt][8 * k + 5]), pg8::cvtpk(sc[kt][8 * k + 6], sc[kt][8 * k + 7])}; }
        lh[half] = swapsum(ls);
        asm volatile("" ::: "memory");
    }
    const float mx = fmaxf(mh[0], mh[1]), f0 = __builtin_amdgcn_exp2f(mh[0] - mx), f1 = __builtin_amdgcn_exp2f(mh[1] - mx);
    const float linv = 1.0f / (f0 * lh[0] + f1 * lh[1]); const float w0 = f0 * linv, w1 = f1 * linv;
    v4u vr[16];
#pragma unroll
    for (int i = 0; i < 16; ++i) { const int e = tid + NTHR * i, d = e >> 5, ch = e & 31; vr[i] = *(const v4u*)(Vt + (size_t)(h * 256 + d) * MROWS + b * MEMLEN + ch * 8); }
    __syncthreads();
#pragma unroll
    for (int i = 0; i < 16; ++i) { const int e = tid + NTHR * i, d = e >> 5, ch = e & 31; const v4u v = vr[i];
        *(LAS v2u*)(L + d * 520 + (ch << 4)) = (v2u){v.x, v.y}; *(LAS v2u*)(L + d * 520 + (ch << 4) + 8) = (v2u){v.z, v.w}; }
    __syncthreads();
    bf16* orow = AO + qrow * D + h * 256;
    const int pr32 = 16 * ((r32 >> 2) & 1) + 4 * (r32 >> 3) + (r32 & 3);
    bf16x8 cur[4], nxt[4];
#define XV_LOAD(f, dt_, q_) { const LAS unsigned char* rowp = L + (32 * (dt_) + pr32) * 520 + (hi << 3); _Pragma("unroll") for (int j = 0; j < 4; ++j) { const int ks = 2 * (q_) + (j >> 1) + 8 * (j & 1); \
        const v2u lo = *(const LAS v2u*)(rowp + (ks << 5)), hh = *(const LAS v2u*)(rowp + (ks << 5) + 16); f[j] = __builtin_bit_cast(bf16x8, (v4u){lo.x, lo.y, hh.x, hh.y}); } }
    XV_LOAD(cur, 0, 0);
    __builtin_amdgcn_sched_barrier(0);
#pragma unroll 1
    for (int dt = 0; dt < 8; ++dt) { f32x16 o0, o1;
#pragma unroll
        for (int r = 0; r < 16; ++r) { o0[r] = 0.f; o1[r] = 0.f; }
#pragma unroll
        for (int q = 0; q < 4; ++q) {
            if (q < 3) XV_LOAD(nxt, dt, q + 1) else XV_LOAD(nxt, (dt + 1) & 7, 0)
            __builtin_amdgcn_sched_barrier(0);
#pragma unroll
            for (int j = 0; j < 4; ++j) { const int ks = 2 * q + (j >> 1) + 8 * (j & 1);
                if (j & 1) o1 = __builtin_amdgcn_mfma_f32_32x32x16_bf16(cur[j], __builtin_bit_cast(bf16x8, pf[ks]), o1, 0, 0, 0);
                else o0 = __builtin_amdgcn_mfma_f32_32x32x16_bf16(cur[j], __builtin_bit_cast(bf16x8, pf[ks]), o0, 0, 0, 0); }
            __builtin_amdgcn_sched_barrier(0);
#pragma unroll
            for (int j = 0; j < 4; ++j) cur[j] = nxt[j]; }
#pragma unroll
        for (int g = 0; g < 2; ++g) { v4u w;
            w.x = pk2(o0[8 * g] * w0 + o1[8 * g] * w1, o0[8 * g + 1] * w0 + o1[8 * g + 1] * w1); w.y = pk2(o0[8 * g + 2] * w0 + o1[8 * g + 2] * w1, o0[8 * g + 3] * w0 + o1[8 * g + 3] * w1);
            w.z = pk2(o0[8 * g + 4] * w0 + o1[8 * g + 4] * w1, o0[8 * g + 5] * w0 + o1[8 * g + 5] * w1); w.w = pk2(o0[8 * g + 6] * w0 + o1[8 * g + 6] * w1, o0[8 * g + 7] * w0 + o1[8 * g + 7] * w1);
            *(v4u*)(orow + 32 * dt + 16 * hi + 8 * g) = w; } }
    __syncthreads();
}

__device__ __forceinline__ void lr_phase(const Args& A, int l, const pg8::u64_t* ssq, int G) {
    typedef _Float16 h8 __attribute__((ext_vector_type(8)));
    int tid = threadIdx.x; asm volatile("" : "+v"(tid));
    const int lane = tid & 63, wave = __builtin_amdgcn_readfirstlane(tid >> 6), i16 = lane & 15, kq = lane >> 4;
    const _Float16* X = (const _Float16*)(A.ws + WS_XB); const _Float16* W = (const _Float16*)(A.ws + WS_WLR) + (size_t)l * 16 * D; bf16* LR = (bf16*)(A.ws + WS_LR);
    for (int rb = blockIdx.x * NWAVES + wave; rb < M / 16; rb += G * NWAVES) {
        const _Float16* xa = X + (size_t)(rb * 16 + i16) * D + 8 * kq; const _Float16* wb = W + (size_t)i16 * D + 8 * kq;
        f32x4 acc = (f32x4){0.f, 0.f, 0.f, 0.f};
        h8 a[32];
#pragma unroll
        for (int s = 0; s < 32; ++s) a[s] = *(const h8*)(xa + 32 * s);
#pragma unroll
        for (int s0 = 0; s0 < 32; s0 += 8) { h8 b[8];
#pragma unroll
            for (int s = 0; s < 8; ++s) b[s] = *(const h8*)(wb + 32 * (s0 + s));
#pragma unroll
            for (int s = 0; s < 8; ++s) acc = __builtin_amdgcn_mfma_f32_16x16x32_f16(a[s0 + s], b[s], acc, 0, 0, 0); }
#pragma unroll
        for (int r = 0; r < 4; ++r) { const int row = rb * 16 + 4 * kq + r; LR[(size_t)row * 16 + i16] = (bf16)f2bf(acc[r] * pg8::rstd_from(ssq[row])); }
    }
}

#define YOUNG_PRIO(p_) do { if (__builtin_amdgcn_readfirstlane((int)threadIdx.x) >= 256) __builtin_amdgcn_s_setprio(p_); } while (0)
typedef const Args __attribute__((address_space(4))) KArgs;
__device__ __forceinline__ Args phase_args() {
#if defined(__HIP_DEVICE_COMPILE__)
    KArgs* kp = (KArgs*)__builtin_amdgcn_kernarg_segment_ptr(); asm volatile("" : "+s"(kp));
    Args a;
#pragma unroll
    for (int i = 0; i < 27; ++i) a.in[i] = kp->in[i];
    a.out = kp->out; a.ws = kp->ws; return a;
#else
    return Args{};
#endif
}
#define PH_ARGS const Args args = phase_args(); unsigned char* const ws = args.ws; unsigned* const ctl = (unsigned*)(ws + WS_CTL); u64* const ssq = (u64*)(ws + WS_SSQ); \
    bf16* const XB = (bf16*)(ws + WS_XB); bf16* const MIX = (bf16*)(ws + WS_MIX); bf16* const BIG = (bf16*)(ws + WS_BIG); const float* const cs = (const float*)(ws + WS_ROPE); const float* const sn = cs + (size_t)M * 8; \
    (void)ctl; (void)ssq; (void)XB; (void)MIX; (void)BIG; (void)cs; (void)sn
__global__ void __launch_bounds__(NTHR, 2) hybrid_fwd(Args kernel_args) {
    extern __shared__ __attribute__((aligned(16))) unsigned char lds_raw[];
    LAS unsigned char* L = (LAS unsigned char*)lds_raw;
    volatile LAS unsigned* MISC = (volatile LAS unsigned*)(L + MISC_OFF);
    const int G = gridDim.x;
    for (int u = threadIdx.x; u < (LDS_BYTES - 139264) / 4; u += NTHR) ((LAS unsigned*)(L + 139264))[u] = 0u;
    __syncthreads();
    XcdBarrier bar = xcd_barrier_post((unsigned*)(kernel_args.ws + WS_CTL) + CW_BAR, MISC + 8);

    { PH_ARGS; p0_prologue(args, L, G); }
    xcd_barrier(bar);

    {   PH_ARGS; pg8::Gemm g{(const bf16*)(ws + WS_MEMN), (const bf16*)(ws + WS_WK), DEPTH * MROWS, DEPTH * D, D}; pg8::DiagOrder S{16, 4, DEPTH, G, (int)blockIdx.x};
        pg8::EpiKV E{(bf16*)(ws + WS_KB), D, 16, 4, (size_t)MROWS * D};
        pg8::gemm_phase<pg8::EpiKV, pg8::DiagOrder, true, true>(L, g, S, E); }
    {   PH_ARGS; pg8::Gemm g{(const bf16*)(ws + WS_WV), (const bf16*)(ws + WS_MEMN), DEPTH * D, DEPTH * MROWS, D}; pg8::DiagOrder S{4, 16, DEPTH, G, (int)((blockIdx.x + 128) % G)};
        pg8::EpiKV E{(bf16*)(ws + WS_VT), MROWS, 4, 16, (size_t)D * MROWS};
        pg8::gemm_phase<pg8::EpiKV, pg8::DiagOrder, true, true>(L, g, S, E); }

    for (int l = 0; l < DEPTH; ++l) {
        {   PH_ARGS; pg8::Gemm g{XB, (const bf16*)(ws + WS_W1 + l * SZ_W1), M, NUP, D}; pg8::StaticOrder S; S.init(M, NUP, G, (int)blockIdx.x);
            pg8::EpiSwiglu E{BIG, DFF, ssq + (size_t)(4 * l) * M};
            pg8::gemm_phase<pg8::EpiSwiglu, pg8::StaticOrder, true, true, true>(L, g, S, E); }
        xcd_barrier(bar);
        {   PH_ARGS; pg8::Gemm g{BIG, (const bf16*)(ws + WS_W2 + l * SZ_W2), M, D, DFF}; pg8::StaticOrder S; S.init(M, D, G, (int)blockIdx.x);
            pg8::EpiResid E{l == 0 ? args.in[0] : nullptr, XB, ssq + (size_t)(4 * l + 1) * M, 0.5f};
            pg8::gemm_phase<pg8::EpiResid, pg8::StaticOrder, true, true>(L, g, S, E); }
        xcd_barrier(bar);
        {   PH_ARGS; pg8::Gemm g{XB, (const bf16*)(ws + WS_WIN + l * SZ_WIN), M, NIN, D}; pg8::StaticOrder S; S.init(M, NIN, G, (int)blockIdx.x);
            pg8::EpiProj E{BIG, NIN, ssq + (size_t)(4 * l + 1) * M, cs, sn, C_DQ / 256, C_DK / 256, 0.125f * LOG2E, 1.0f};
            pg8::gemm_phase<pg8::EpiProj, pg8::StaticOrder, true, true, true>(L, g, S, E);
            lr_phase(args, l, ssq + (size_t)(4 * l + 1) * M, G);
            }
        xcd_barrier(bar);
        {   PH_ARGS; YOUNG_PRIO(1);
            {   int tidl = threadIdx.x; asm volatile("" : "+v"(tidl)); const int wave = __builtin_amdgcn_readfirstlane(tidl >> 6); LAS unsigned char* WL = L + wave * 16384;
                for (int task = blockIdx.x * NWAVES + wave; task < 2048; task += G * NWAVES) { scan_taskA<64, true>(args, l, task >> 5, task & 31, WL); scan_taskA<32, false>(args, l, task >> 5, task & 31, WL); } }
            __syncthreads();
            for (int u = blockIdx.x; u < 1024; u += G) conv_unit(args, l, u, L);
            YOUNG_PRIO(0); }
        xcd_barrier(bar);
        {   PH_ARGS; YOUNG_PRIO(1);
            scan_phaseB(args, G);
            for (int p = blockIdx.x; p < 256; p += G) { const int bh = p & 63, k = p >> 6;
                dattn_unit(args, bh * 8 + 7 - k, L); dattn_unit(args, bh * 8 + k, L); }
            YOUNG_PRIO(0); }
        xcd_barrier(bar);
        {   PH_ARGS; YOUNG_PRIO(1); int tidl = threadIdx.x; asm volatile("" : "+v"(tidl)); const int wave = __builtin_amdgcn_readfirstlane(tidl >> 6); LAS unsigned char* WL = L + wave * 16384;
            for (int task = blockIdx.x * NWAVES + wave; task < 2048; task += G * NWAVES) { scan_taskC<64, true>(args, l, task >> 5, task & 31, WL); scan_taskC<32, false>(args, l, task >> 5, task & 31, WL); } YOUNG_PRIO(0); }
        xcd_barrier(bar);
        {   PH_ARGS; pg8::Gemm g{MIX, (const bf16*)(ws + WS_WOUT + l * SZ_SQ), M, D, D}; pg8::StaticOrder S; S.init(M, D, G, (int)blockIdx.x);
            pg8::EpiResid E{nullptr, XB, ssq + (size_t)(4 * l + 2) * M, 1.0f};
            pg8::gemm_phase<pg8::EpiResid, pg8::StaticOrder, true, true>(L, g, S, E); }
        xcd_barrier(bar);
        {   PH_ARGS; pg8::Gemm g{XB, (const bf16*)(ws + WS_WQ + l * SZ_SQ), M, D, D}; pg8::StaticOrder S; S.init(M, D, G, (int)blockIdx.x);
            pg8::EpiProj E{BIG, D, ssq + (size_t)(4 * l + 2) * M, cs, sn, -1, -1, 1.0f, 0.0625f * LOG2E};
            pg8::gemm_phase<pg8::EpiProj, pg8::StaticOrder, true, true, true>(L, g, S, E); }
        __syncthreads();
        {   PH_ARGS; pg8::StaticOrder S; S.init(M, D, G, (int)blockIdx.x); pg8::Unit u;
            YOUNG_PRIO(1); for (int i = 0; S.next(i, u); ++i) xattn_unit(args, l, ((u.pm >> 3) * 4 + u.pn) * 8 + (u.pm & 7), L); YOUNG_PRIO(0); }
        xcd_barrier(bar);
        {   PH_ARGS; pg8::Gemm g{(const bf16*)(ws + WS_BIG + 64 * MiB), (const bf16*)(ws + WS_WO + l * SZ_SQ), M, D, D}; pg8::StaticOrder S; S.init(M, D, G, (int)blockIdx.x);
            pg8::EpiResid E{nullptr, XB, ssq + (size_t)(4 * l + 3) * M, 1.0f};
            pg8::gemm_phase<pg8::EpiResid, pg8::StaticOrder, true, true>(L, g, S, E); }
        xcd_barrier(bar);
        {   PH_ARGS; pg8::Gemm g{XB, (const bf16*)(ws + WS_W3 + l * SZ_W1), M, NUP, D}; pg8::StaticOrder S; S.init(M, NUP, G, (int)blockIdx.x);
            pg8::EpiSwiglu E{BIG, DFF, ssq + (size_t)(4 * l + 3) * M};
            pg8::gemm_phase<pg8::EpiSwiglu, pg8::StaticOrder, true, true, true>(L, g, S, E); }
        xcd_barrier(bar);
        {   PH_ARGS; pg8::Gemm g{BIG, (const bf16*)(ws + WS_W4 + l * SZ_W2), M, D, DFF}; pg8::StaticOrder S; S.init(M, D, G, (int)blockIdx.x);
            pg8::EpiResid E{nullptr, XB, ssq + (size_t)(4 * l + 4) * M, 0.5f};
            pg8::gemm_phase<pg8::EpiResid, pg8::StaticOrder, true, true>(L, g, S, E); }
        xcd_barrier(bar);
    }
    {   PH_ARGS;
        int tid = threadIdx.x; asm volatile("" : "+v"(tid));
        const int lane = tid & 63, wave = __builtin_amdgcn_readfirstlane(tid >> 6);
        const int gw = blockIdx.x * NWAVES + wave, NGW = G * NWAVES;
        const f32x4* gr = (const f32x4*)args.in[26] + lane;
        f32x4 gv[4];
#pragma unroll
        for (int j = 0; j < 4; ++j) gv[j] = gr[64 * j];
        for (int m = gw; m < M; m += 4 * NGW) {
            v2u hv[4][4];
#pragma unroll
            for (int q = 0; q < 4; ++q) { const int mq = m + q * NGW < M ? m + q * NGW : m; const v2u* hr = (const v2u*)(XB + (size_t)mq * D) + lane;
#pragma unroll
                for (int j = 0; j < 4; ++j) hv[q][j] = hr[64 * j]; }
#pragma unroll
            for (int q = 0; q < 4; ++q) { const int mq = m + q * NGW; if (mq >= M) break; f32x4* orow = (f32x4*)(args.out + (size_t)mq * D) + lane; f32x4 v[4]; float ss = 0.f;
#pragma unroll
                for (int j = 0; j < 4; ++j) { const pg8::f32x2 a = pg8::unpk_h(hv[q][j].x), b = pg8::unpk_h(hv[q][j].y); v[j] = (f32x4){a.x, a.y, b.x, b.y}; ss += (v[j][0] * v[j][0] + v[j][1] * v[j][1]) + (v[j][2] * v[j][2] + v[j][3] * v[j][3]); }
                const float rs = 1.0f / sqrtf(wave_sum(ss) * (1.0f / D) + EPS);
#pragma unroll
                for (int j = 0; j < 4; ++j) orow[64 * j] = v[j] * rs * gv[j]; } }
    }
}

extern "C" void kernel_launch(void* const* d_in, const int* in_sizes, int n_in, void* d_out, int out_size, void* d_ws, size_t ws_size, hipStream_t stream) {
    static int grid = 0;
    if (grid == 0) {
        if (n_in != 27 || out_size != M * D || ws_size < WS_END) { fprintf(stderr, "kernel_launch: unexpected problem (n_in %d, out %d, ws %zu)\n", n_in, out_size, ws_size); grid = -1; return; }
        int dev = 0, cus = 0, per_cu = 0;
        if (hipGetDevice(&dev) != hipSuccess || hipDeviceGetAttribute(&cus, hipDeviceAttributeMultiprocessorCount, dev) != hipSuccess) { grid = -1; return; }
        if (hipFuncSetAttribute((const void*)hybrid_fwd, hipFuncAttributeMaxDynamicSharedMemorySize, LDS_BYTES) != hipSuccess) { fprintf(stderr, "kernel_launch: hipFuncSetAttribute failed\n"); grid = -1; return; }
        if (hipOccupancyMaxActiveBlocksPerMultiprocessor(&per_cu, (const void*)hybrid_fwd, NTHR, LDS_BYTES) != hipSuccess || per_cu < 1) { fprintf(stderr, "kernel_launch: occupancy query reports %d\n", per_cu); }
        (void)hipGetLastError();
        grid = cus;
    }
    if (grid < 0) return;
    if (hipMemsetAsync((char*)d_ws + WS_CTL, 0, CTL_ZERO_BYTES, stream) != hipSuccess) return;
    Args a{};
    for (int i = 0; i < 27; ++i) a.in[i] = (const float*)d_in[i];
    a.out = (float*)d_out; a.ws = (unsigned char*)d_ws;
    hipLaunchKernelGGL(hybrid_fwd, dim3(grid), dim3(NTHR), LDS_BYTES, stream, a);
}
```

```cpp
#include <hip/hip_runtime.h>
#include <cstdio>
#include <cstdint>
namespace pg8 {
#define PG8_LAS __attribute__((address_space(3)))
typedef unsigned short bf16_t;
typedef short bf16x8 __attribute__((ext_vector_type(8)));
typedef float f32x4 __attribute__((ext_vector_type(4)));
typedef unsigned u32x4 __attribute__((ext_vector_type(4)));
constexpr int BM = 256, BK = 64, HALF = 128, HTB = HALF * BK * 2  , STAGE_BYTES = 8 * HTB, NXCD = 8, WGM = 8;

__host__ __device__ __forceinline__ int lds_byte(int r, int c) { const int st = (r >> 4) * 2 + (c >> 5), rr = r & 15, cc = c & 31, ob = rr * 64 + cc * 2; return st * 1024 + (ob ^ (((ob >> 9) & 1) << 5)); }
__host__ __device__ __forceinline__ void stage_rc(int b, int& R, int& C) { const int st = b / 1024, sb = b % 1024, swz = sb ^ (((sb >> 9) & 1) << 5); R = (st >> 1) * 16 + swz / 64; C = (st & 1) * 32 + (swz % 64) / 2; }
__host__ __device__ __forceinline__ int perm32(int rho) { const int n = rho >> 4, i = rho & 15; return 8 * (i >> 2) + 4 * n + (i & 3); }

struct Unit { int pm, pn; };
struct Gemm { const bf16_t* A; const bf16_t* Bt; int M, N, K; };

struct StaticOrder {
    int nM, nN, nwg, G, c;
    __host__ __device__ void init(int M, int N, int G_, int c_) { nM = M / BM; nN = N / BM; nwg = nM * nN; G = G_; c = c_; }
    __host__ __device__ bool next(int i, Unit& u) const {
        const long L = (long)i * G + c; if (L >= nwg) return false;
        int wgid = (int)L; { const int q = nwg / NXCD, r = nwg % NXCD, xcd = wgid % NXCD, off = wgid / NXCD; wgid = (xcd < r ? xcd * (q + 1) : r * (q + 1) + (xcd - r) * q) + off; }
        const int nig = WGM * nN, gid = wgid / nig, fm = gid * WGM, gsz = (nM - fm) < WGM ? (nM - fm) : WGM;
        u.pm = fm + ((wgid % nig) % gsz); u.pn = (wgid % nig) / gsz; return true;
    }
    __device__ __forceinline__ void a_ready(const Unit&) const {}
    __device__ __forceinline__ void done(const Unit&) const {}
};

__device__ __forceinline__ unsigned cvt_pk_bf16(float lo, float hi) { unsigned r; asm volatile("v_cvt_pk_bf16_f32 %0, %1, %2" : "=v"(r) : "v"(lo), "v"(hi)); return r; }
typedef float f32x2 __attribute__((ext_vector_type(2)));
typedef unsigned long long u64_t;
typedef _Float16 f16x8 __attribute__((ext_vector_type(8)));
typedef _Float16 f16x2_t __attribute__((ext_vector_type(2)));
__device__ __forceinline__ unsigned cvtpk_h(float lo, float hi) { f32x2 v = {lo, hi}; f16x2_t h = __builtin_convertvector(v, f16x2_t); return __builtin_bit_cast(unsigned, h); }
__device__ __forceinline__ f32x2 unpk_h(unsigned w) { f16x2_t h = __builtin_bit_cast(f16x2_t, w); return __builtin_convertvector(h, f32x2); }
typedef __bf16 bf16x2_t __attribute__((ext_vector_type(2)));
__device__ __forceinline__ unsigned cvtpk(float lo, float hi) { f32x2 v = {lo, hi}; bf16x2_t b = __builtin_convertvector(v, bf16x2_t); return __builtin_bit_cast(unsigned, b); }
typedef unsigned u32x2 __attribute__((ext_vector_type(2)));
constexpr float SSQ_SCALE = 1048576.0f;
__device__ __forceinline__ float rstd_from(u64_t v) { const float ms = ((float)(unsigned)(v >> 32) * 4294967296.0f + (float)(unsigned)v) * (1.0f / (SSQ_SCALE * 1024.0f)); return __builtin_amdgcn_rsqf(ms + 1e-6f); }
__device__ __forceinline__ float silu_f(float x) { return x * __builtin_amdgcn_rcpf(1.0f + __builtin_amdgcn_exp2f(-1.4426950408889634f * x)); }

struct EpiSwiglu {
    static constexpr bool PERM = true, AFTER_DRAIN = false;
    bf16_t* H; int ldh; const u64_t* ssq;
    __device__ __forceinline__ void operator()(const f32x4 (&acc)[2][2][4][2], const Unit& u, int wr, int wc, int fr, int fq) const {
        const int row0 = u.pm * BM + wr * 64 + fr, col0 = u.pn * HALF + wc * 32 + 8 * fq;
        u64_t sq[2][4];
#pragma unroll
        for (int ai = 0; ai < 2; ++ai)
#pragma unroll
            for (int m = 0; m < 4; ++m) sq[ai][m] = ssq[row0 + ai * HALF + m * 16];
#pragma unroll
        for (int ai = 0; ai < 2; ++ai)
#pragma unroll
            for (int m = 0; m < 4; ++m) { const int row = row0 + ai * HALF + m * 16; const float rs = rstd_from(sq[ai][m]);
                const f32x4 g0 = acc[ai][0][m][0] * rs, g1 = acc[ai][0][m][1] * rs, u0 = acc[ai][1][m][0] * rs, u1 = acc[ai][1][m][1] * rs;
                u32x4 w;
                w.x = cvtpk(silu_f(g0[0]) * u0[0], silu_f(g0[1]) * u0[1]); w.y = cvtpk(silu_f(g0[2]) * u0[2], silu_f(g0[3]) * u0[3]);
                w.z = cvtpk(silu_f(g1[0]) * u1[0], silu_f(g1[1]) * u1[1]); w.w = cvtpk(silu_f(g1[2]) * u1[2], silu_f(g1[3]) * u1[3]);
                __builtin_nontemporal_store(w, (u32x4*)(H + (size_t)row * ldh + col0)); }
    }
};
struct EpiResid {
    static constexpr bool PERM = true, AFTER_DRAIN = false;
    const float* X32; bf16_t* X16; u64_t* ssq_out; float scale;
    __device__ __forceinline__ void operator()(const f32x4 (&acc)[2][2][4][2], const Unit& u, int wr, int wc, int fr, int fq) const {
        const int row0 = u.pm * BM + wr * 64 + fr, col0 = u.pn * BM + wc * 32 + 8 * fq;
        if (X32) {
#pragma unroll
            for (int ai = 0; ai < 2; ++ai)
#pragma unroll
                for (int m = 0; m < 4; ++m) { const int row = row0 + ai * HALF + m * 16; bf16_t* hr = X16 + (size_t)row * 1024 + col0; float ss = 0.f;
#pragma unroll
                    for (int bj = 0; bj < 2; ++bj) { const float* xp = X32 + (size_t)row * 1024 + col0 + bj * HALF; f32x4 x0 = *(const f32x4*)xp, x1 = *(const f32x4*)(xp + 4);
                        x0 = x0 + acc[ai][bj][m][0] * scale; x1 = x1 + acc[ai][bj][m][1] * scale;
                        u32x4 w; w.x = cvtpk_h(x0[0], x0[1]); w.y = cvtpk_h(x0[2], x0[3]); w.z = cvtpk_h(x1[0], x1[1]); w.w = cvtpk_h(x1[2], x1[3]); *(u32x4*)(hr + bj * HALF) = w;
                        ss += ((x0[0] * x0[0] + x0[1] * x0[1]) + (x0[2] * x0[2] + x0[3] * x0[3])) + ((x1[0] * x1[0] + x1[1] * x1[1]) + (x1[2] * x1[2] + x1[3] * x1[3])); }
                    ss += __shfl_xor(ss, 16); ss += __shfl_xor(ss, 32);
                    if (fq == 0) atomicAdd(ssq_out + row, (u64_t)(ss * SSQ_SCALE + 0.5f));
                    asm volatile("" ::: "memory"); }
            return; }
#pragma unroll
        for (int ai = 0; ai < 2; ++ai) { u32x4 hv[4][2];
#pragma unroll
            for (int m = 0; m < 4; ++m)
#pragma unroll
                for (int bj = 0; bj < 2; ++bj) hv[m][bj] = *(const u32x4*)(X16 + (size_t)(row0 + ai * HALF + m * 16) * 1024 + col0 + bj * HALF);
#pragma unroll
            for (int m = 0; m < 4; ++m) { const int row = row0 + ai * HALF + m * 16; bf16_t* hr = X16 + (size_t)row * 1024 + col0; float ss = 0.f;
#pragma unroll
                for (int bj = 0; bj < 2; ++bj) { const u32x4 h4 = hv[m][bj]; const f32x2 a = unpk_h(h4.x), b = unpk_h(h4.y), c = unpk_h(h4.z), d = unpk_h(h4.w);
                    f32x4 x0 = (f32x4){a.x, a.y, b.x, b.y}, x1 = (f32x4){c.x, c.y, d.x, d.y};
                    x0 = x0 + acc[ai][bj][m][0] * scale; x1 = x1 + acc[ai][bj][m][1] * scale;
                    u32x4 w; w.x = cvtpk_h(x0[0], x0[1]); w.y = cvtpk_h(x0[2], x0[3]); w.z = cvtpk_h(x1[0], x1[1]); w.w = cvtpk_h(x1[2], x1[3]); *(u32x4*)(hr + bj * HALF) = w;
                    ss += ((x0[0] * x0[0] + x0[1] * x0[1]) + (x0[2] * x0[2] + x0[3] * x0[3])) + ((x1[0] * x1[0] + x1[1] * x1[1]) + (x1[2] * x1[2] + x1[3] * x1[3])); }
                ss += __shfl_xor(ss, 16); ss += __shfl_xor(ss, 32);
                if (fq == 0) atomicAdd(ssq_out + row, (u64_t)(ss * SSQ_SCALE + 0.5f)); }
            asm volatile("" ::: "memory"); }
    }
};
struct EpiProj {
    static constexpr bool PERM = true, AFTER_DRAIN = false;
    bf16_t* O; int ldo; const u64_t* ssq; const float* cs; const float* sn; int tq, tk; float qscale, gscale;
    __device__ __forceinline__ void operator()(const f32x4 (&acc)[2][2][4][2], const Unit& u, int wr, int wc, int fr, int fq) const {
        const int row0 = u.pm * BM + wr * 64 + fr, col0 = u.pn * BM + wc * 32 + 8 * fq;
        const bool rope = (u.pn == tq || u.pn == tk) && ((wc & 1) == 0) && (fq < 2);
        const float osc = ((u.pn == tq) ? qscale : 1.0f) * gscale;
        u64_t sq[2][4];
#pragma unroll
        for (int ai = 0; ai < 2; ++ai)
#pragma unroll
            for (int m = 0; m < 4; ++m) sq[ai][m] = ssq[row0 + ai * HALF + m * 16];
#pragma unroll
        for (int g = 0; g < 4; ++g) { const int ai = g >> 1; f32x4 cr[2], sr[2];
#pragma unroll
            for (int mm = 0; mm < 2; ++mm) { const int row = row0 + ai * HALF + (2 * (g & 1) + mm) * 16; cr[mm] = (f32x4){1.f, 1.f, 1.f, 1.f}; sr[mm] = (f32x4){0.f, 0.f, 0.f, 0.f};
                if (rope) { cr[mm] = *(const f32x4*)(cs + (size_t)row * 8 + 4 * fq); sr[mm] = *(const f32x4*)(sn + (size_t)row * 8 + 4 * fq); } }
#pragma unroll
            for (int mm = 0; mm < 2; ++mm) { const int m = 2 * (g & 1) + mm; const int row = row0 + ai * HALF + m * 16; const float rs = rstd_from(sq[ai][m]) * osc;
                const f32x4 c4 = cr[mm], s4 = sr[mm];
#pragma unroll
                for (int bj = 0; bj < 2; ++bj) { const f32x4 a = acc[ai][bj][m][0] * rs, b = acc[ai][bj][m][1] * rs;
                    const f32x4 v0 = rope ? (a * c4 - b * s4) : a, v1 = rope ? (b * c4 + a * s4) : b;
                    u32x4 w; w.x = cvtpk(v0[0], v0[1]); w.y = cvtpk(v0[2], v0[3]); w.z = cvtpk(v1[0], v1[1]); w.w = cvtpk(v1[2], v1[3]);
                    *(u32x4*)(O + (size_t)row * ldo + col0 + bj * HALF) = w; } } }
    }
};
struct EpiKV {
    static constexpr bool PERM = true, AFTER_DRAIN = false;
    bf16_t* O; int ldo; int tpm, tpn; size_t lstride;
    __device__ __forceinline__ void operator()(const f32x4 (&acc)[2][2][4][2], const Unit& u, int wr, int wc, int fr, int fq) const {
        const int l = u.pm / tpm; bf16_t* base = O + (size_t)l * lstride;
        const int row0 = (u.pm - l * tpm) * BM + wr * 64 + fr, col0 = (u.pn - l * tpn) * BM + wc * 32 + 8 * fq;
#pragma unroll
        for (int ai = 0; ai < 2; ++ai)
#pragma unroll
            for (int m = 0; m < 4; ++m) { bf16_t* rowp = base + (size_t)(row0 + ai * HALF + m * 16) * ldo + col0;
#pragma unroll
                for (int bj = 0; bj < 2; ++bj) { const f32x4 v0 = acc[ai][bj][m][0], v1 = acc[ai][bj][m][1];
                    u32x4 w; w.x = cvtpk(v0[0], v0[1]); w.y = cvtpk(v0[2], v0[3]); w.z = cvtpk(v1[0], v1[1]); w.w = cvtpk(v1[2], v1[3]);
                    *(u32x4*)(rowp + bj * HALF) = w; } }
    }
};
struct DiagOrder {
    int tpm, tpn, nl, G, c;
    __device__ __forceinline__ bool next(int i, Unit& u) const {
        const int L = i * G + c, per = tpm * tpn; if (L >= nl * per) return false;
        const int l = L / per, r = L % per; u.pm = l * tpm + r % tpm; u.pn = l * tpn + r / tpm; return true; }
    __device__ __forceinline__ void a_ready(const Unit&) const {}
    __device__ __forceinline__ void done(const Unit&) const {}
};
template <class Epi, class Sched, bool ALIGN_EPI = false, bool SP2 = false, bool F16 = false>
__device__ __forceinline__ void gemm_phase(PG8_LAS unsigned char* lds, const Gemm g, const Sched& S, const Epi& E) {
    int tid_l = threadIdx.x; asm volatile("" : "+v"(tid_l));
    const int tid = tid_l, wid = __builtin_amdgcn_readfirstlane(tid >> 6), lane = tid & 63, wr = wid >> 2, wc = wid & 3, fr = lane & 15, fq = lane >> 4;
    const int K = g.K, nt = K / BK;
    unsigned voffA[2], voffB[2];
#pragma unroll
    for (int i = 0; i < 2; ++i) { int R, C; stage_rc(tid * 16 + i * 8192, R, C); const int Rb = Epi::PERM ? ((R & ~31) + perm32(R & 31)) : R;
        voffA[i] = (unsigned)(R * K + C) * 2u; voffB[i] = (unsigned)(Rb * K + C) * 2u; }
    const size_t kstep = (size_t)(BK * 2);
    const size_t hstep = (size_t)HALF * K * 2;
    const size_t tstep = 2 * hstep;
    const unsigned ldsw = (unsigned)wid * 1024u;
    const int aoff = lds_byte(wr * 64 + fr, fq * 8), boff = lds_byte(wc * 32 + fr, fq * 8);
#define PG8_SA(b, h) (((b) * 2 + (h)) * HTB)
#define PG8_SB(b, h) ((4 + (b) * 2 + (h)) * HTB)
#define PG8_STAGE(bufoff, gbase, voff) do { _Pragma("unroll") for (int _i = 0; _i < 2; ++_i) \
        __builtin_amdgcn_global_load_lds((const unsigned*)((const char*)(gbase) + (voff)[_i]), (PG8_LAS unsigned*)(lds + (bufoff) + ldsw + _i * 8192), 16, 0, 0); } while (0)
#define PG8_LDA(dst, b, h) do { _Pragma("unroll") for (int m = 0; m < 4; ++m) _Pragma("unroll") for (int k = 0; k < 2; ++k) dst[m][k] = *(const PG8_LAS bf16x8*)(lds + PG8_SA(b, h) + aoff + m * 2048 + k * 1024); } while (0)
#define PG8_LDB(dst, b, h) do { _Pragma("unroll") for (int n = 0; n < 2; ++n) _Pragma("unroll") for (int k = 0; k < 2; ++k) dst[n][k] = *(const PG8_LAS bf16x8*)(lds + PG8_SB(b, h) + boff + n * 2048 + k * 1024); } while (0)
#define PG8_MMA(ai, bj, At, Bt) do { __builtin_amdgcn_s_setprio(1); _Pragma("unroll") for (int m = 0; m < 4; ++m) _Pragma("unroll") for (int n = 0; n < 2; ++n) _Pragma("unroll") for (int k = 0; k < 2; ++k) \
        acc[ai][bj][m][n] = F16 ? __builtin_amdgcn_mfma_f32_16x16x32_f16(__builtin_bit_cast(f16x8, Bt[n][k]), __builtin_bit_cast(f16x8, At[m][k]), acc[ai][bj][m][n], 0, 0, 0) \
                                : __builtin_amdgcn_mfma_f32_16x16x32_bf16(Bt[n][k], At[m][k], acc[ai][bj][m][n], 0, 0, 0); __builtin_amdgcn_s_setprio(0); } while (0)
#define PG8_WAIT_V(n) asm volatile("s_waitcnt vmcnt(" #n ")" ::: "memory")
#define PG8_WAIT_L(n) asm volatile("s_waitcnt lgkmcnt(" #n ")" ::: "memory")
#define PG8_BAR __builtin_amdgcn_s_barrier()
#define PG8_SCHED __builtin_amdgcn_sched_barrier(0)
    Unit cur, nxt; int ui = 0;
    if (!S.next(0, cur)) return;
    f32x4 acc[2][2][4][2];
#pragma unroll
    for (int a = 0; a < 2; ++a)
#pragma unroll
        for (int b = 0; b < 2; ++b)
#pragma unroll
            for (int m = 0; m < 4; ++m)
#pragma unroll
                for (int n = 0; n < 2; ++n) acc[a][b][m][n] = (f32x4){0.f, 0.f, 0.f, 0.f};
    bf16x8 At[4][2], B0[2][2], B1[2][2];
    const char* cA = (const char*)g.A + (size_t)cur.pm * tstep; const char* cB = (const char*)g.Bt + (size_t)cur.pn * tstep;
    S.a_ready(cur);
    if constexpr (SP2) {
        PG8_STAGE(PG8_SB(0, 0), cB, voffB); PG8_STAGE(PG8_SB(0, 1), cB + hstep, voffB); PG8_STAGE(PG8_SA(0, 0), cA, voffA); PG8_STAGE(PG8_SA(0, 1), cA + hstep, voffA);
        if (wr == 1) PG8_BAR;
        PG8_WAIT_V(2); PG8_BAR;
        PG8_STAGE(PG8_SB(1, 0), cB + kstep, voffB); PG8_STAGE(PG8_SA(1, 0), cA + kstep, voffA); PG8_STAGE(PG8_SB(1, 1), cB + hstep + kstep, voffB);
        PG8_WAIT_V(6); PG8_BAR;
    } else {
        PG8_STAGE(PG8_SB(0, 0), cB, voffB); PG8_STAGE(PG8_SA(0, 0), cA, voffA); PG8_STAGE(PG8_SB(0, 1), cB + hstep, voffB); PG8_STAGE(PG8_SA(0, 1), cA + hstep, voffA);
        if (wr == 1) PG8_BAR;
        PG8_WAIT_V(4); PG8_BAR;
        PG8_STAGE(PG8_SB(1, 0), cB + kstep, voffB); PG8_STAGE(PG8_SA(1, 0), cA + kstep, voffA); PG8_STAGE(PG8_SB(1, 1), cB + hstep + kstep, voffB);
        PG8_WAIT_V(6); PG8_BAR;
    }
    for (;;) {
        const bool has_next = S.next(ui + 1, nxt);
        const char* nA = has_next ? (const char*)g.A + (size_t)nxt.pm * tstep : cA; const char* nB = has_next ? (const char*)g.Bt + (size_t)nxt.pn * tstep : cB;
        for (int t = 0; t < nt; t += 2) {
            const bool last = (t == nt - 2);
            const char* a1 = cA + (size_t)(t + 1) * kstep;
            const char* a2 = last ? nA : cA + (size_t)(t + 2) * kstep; const char* b2 = last ? nB : cB + (size_t)(t + 2) * kstep;
            const char* a3 = a2 + kstep; const char* b3 = b2 + kstep;
            if (last && has_next) S.a_ready(nxt);
            if constexpr (SP2) {
            PG8_LDB(B0, 0, 0); PG8_LDB(B1, 0, 1); PG8_SCHED; PG8_LDA(At, 0, 0); PG8_STAGE(PG8_SA(1, 1), a1 + hstep, voffA);
            PG8_WAIT_V(8); PG8_WAIT_L(0); PG8_BAR; PG8_MMA(0, 0, At, B0); PG8_MMA(0, 1, At, B1); PG8_BAR; PG8_SCHED;
            PG8_LDA(At, 0, 1); PG8_STAGE(PG8_SB(0, 0), b2, voffB); PG8_STAGE(PG8_SB(0, 1), b2 + hstep, voffB); PG8_STAGE(PG8_SA(0, 0), a2, voffA);
            PG8_WAIT_V(8); PG8_WAIT_L(0); PG8_BAR; PG8_MMA(1, 0, At, B0); PG8_MMA(1, 1, At, B1); PG8_BAR; PG8_SCHED;
            PG8_LDB(B0, 1, 0); PG8_LDB(B1, 1, 1); PG8_SCHED; PG8_LDA(At, 1, 0); PG8_STAGE(PG8_SA(0, 1), a2 + hstep, voffA);
            PG8_WAIT_V(8); PG8_WAIT_L(0); PG8_BAR; PG8_MMA(0, 0, At, B0); PG8_MMA(0, 1, At, B1); PG8_BAR; PG8_SCHED;
            PG8_LDA(At, 1, 1); PG8_STAGE(PG8_SB(1, 0), b3, voffB); PG8_STAGE(PG8_SB(1, 1), b3 + hstep, voffB); PG8_STAGE(PG8_SA(1, 0), a3, voffA);
            PG8_WAIT_V(8); PG8_WAIT_L(0); PG8_BAR; PG8_MMA(1, 0, At, B0); PG8_MMA(1, 1, At, B1); PG8_BAR; PG8_SCHED;
            } else {
            PG8_LDB(B0, 0, 0); PG8_SCHED; PG8_LDA(At, 0, 0); PG8_STAGE(PG8_SA(1, 1), a1 + hstep, voffA);
            PG8_WAIT_L(8); PG8_BAR; PG8_WAIT_L(0); PG8_MMA(0, 0, At, B0); PG8_BAR; PG8_SCHED;
            PG8_LDB(B1, 0, 1); PG8_STAGE(PG8_SB(0, 0), b2, voffB);
            PG8_BAR; PG8_WAIT_L(0); PG8_MMA(0, 1, At, B1); PG8_BAR;
            PG8_LDA(At, 0, 1); PG8_STAGE(PG8_SA(0, 0), a2, voffA);
            PG8_BAR; PG8_WAIT_L(0); PG8_MMA(1, 0, At, B0); PG8_BAR; PG8_SCHED;
            PG8_STAGE(PG8_SB(0, 1), b2 + hstep, voffB);
            PG8_WAIT_V(6); PG8_BAR; PG8_MMA(1, 1, At, B1); PG8_BAR;
            PG8_LDB(B0, 1, 0); PG8_SCHED; PG8_LDA(At, 1, 0); PG8_STAGE(PG8_SA(0, 1), a2 + hstep, voffA);
            PG8_WAIT_L(8); PG8_BAR; PG8_WAIT_L(0); PG8_MMA(0, 0, At, B0); PG8_BAR; PG8_SCHED;
            PG8_LDB(B1, 1, 1); PG8_STAGE(PG8_SB(1, 0), b3, voffB);
            PG8_BAR; PG8_WAIT_L(0); PG8_MMA(0, 1, At, B1); PG8_BAR;
            PG8_LDA(At, 1, 1); PG8_STAGE(PG8_SA(1, 0), a3, voffA);
            PG8_BAR; PG8_WAIT_L(0); PG8_MMA(1, 0, At, B0); PG8_BAR; PG8_SCHED;
            PG8_STAGE(PG8_SB(1, 1), b3 + hstep, voffB);
            PG8_WAIT_V(6); PG8_BAR; PG8_MMA(1, 1, At, B1); PG8_BAR;
            }
        }
        if constexpr (ALIGN_EPI) { if (wr == 0) PG8_BAR; }
        if constexpr (!Epi::AFTER_DRAIN) { E(acc, cur, wr, wc, fr, fq); S.done(cur); }
        if (!has_next) break;
#pragma unroll
        for (int a = 0; a < 2; ++a)
#pragma unroll
            for (int b = 0; b < 2; ++b)
#pragma unroll
                for (int m = 0; m < 4; ++m)
#pragma unroll
                    for (int n = 0; n < 2; ++n) acc[a][b][m][n] = (f32x4){0.f, 0.f, 0.f, 0.f};
        cur = nxt; cA = nA; cB = nB; ++ui;
        if constexpr (ALIGN_EPI) { if (wr == 1) PG8_BAR; }
    }
    PG8_WAIT_V(0);
    if constexpr (!ALIGN_EPI) { if (wr == 0) PG8_BAR; }
    PG8_BAR;
    if constexpr (Epi::AFTER_DRAIN) { E.fused(acc, cur, wr, wc, fr, fq, lds, wid, lane); S.done(cur); }
#undef PG8_SA
#undef PG8_SB
#undef PG8_STAGE
#undef PG8_LDA
#undef PG8_LDB
#undef PG8_MMA
#undef PG8_WAIT_V
#undef PG8_WAIT_L
#undef PG8_BAR
#undef PG8_SCHED
}
}
#define XB_TMO      128
#define XB_XCNT(j)  (256  + 64 * (j))
#define XB_XSUB(j)  (1280 + 64 * (j))
#define XB_XGEN(j)  (2304 + 64 * (j))
#define XB_TOP      3328
#define XB_TOPGEN   3392
#define XCD_BAR_WORDS 3456
#define XB_SPIN_CAP (1u << 18)
#define LAS __attribute__((address_space(3)))

__device__ __forceinline__ unsigned xb_ld(unsigned* p)              { return __hip_atomic_load(p, __ATOMIC_RELAXED, __HIP_MEMORY_SCOPE_AGENT); }
__device__ __forceinline__ unsigned xb_add(unsigned* p, unsigned v) { return __hip_atomic_fetch_add(p, v, __ATOMIC_RELAXED, __HIP_MEMORY_SCOPE_AGENT); }
__device__ __forceinline__ unsigned xb_xcc_id() { return (unsigned)__builtin_amdgcn_s_getreg((3 << 11) | 20) & 0xFu; }
#define XB_SPIN(cond, bar) do { unsigned _sp = 0; while (cond) { __builtin_amdgcn_s_sleep(1); \
    if ((++_sp & 255u) == 0u) { if (xb_ld(&(bar)[XB_TMO])) break; if (_sp > XB_SPIN_CAP) { atomicAdd(&(bar)[XB_TMO], 1u); break; } } } } while (0)

struct XcdBarrier {
    unsigned* bar; unsigned x;
    volatile LAS unsigned* st;
};

__device__ __forceinline__ XcdBarrier xcd_barrier_post(unsigned* bar, volatile LAS unsigned* st) {
    XcdBarrier b; b.bar = bar; b.x = xb_xcc_id(); b.st = st;
    if (threadIdx.x == 0) (void)xb_add(&bar[XB_XCNT(b.x)], 1u);
    return b;
}
__device__ __forceinline__ void xcd_barrier_complete(unsigned* bar, unsigned x, unsigned& nloc, unsigned& nx) {
    const unsigned G = gridDim.x * gridDim.y * gridDim.z;
    unsigned sum, cnt, mine, sp = 0u;
    for (;;) {
        sum = 0u; cnt = 0u; mine = 0u;
#pragma unroll
        for (unsigned j = 0; j < 16; ++j) { const unsigned c = xb_ld(&bar[XB_XCNT(j)]); sum += c; cnt += (c > 0u) ? 1u : 0u; mine = (j == x) ? c : mine; }
        if (sum == G) break;
        __builtin_amdgcn_s_sleep(1);
        if ((++sp & 255u) == 0u) { if (xb_ld(&bar[XB_TMO])) break; if (sp > XB_SPIN_CAP) { atomicAdd(&bar[XB_TMO], 1u); break; } }
    }
    nloc = mine > 0u ? mine : 1u; nx = cnt > 0u ? cnt : 1u;
}

__device__ __forceinline__ void xcd_barrier(const XcdBarrier& b) {
    asm volatile("s_waitcnt vmcnt(0)" ::: "memory");
    __syncthreads();
    if (threadIdx.x == 0) {
        unsigned* bar = b.bar;
        __builtin_amdgcn_s_waitcnt(0);
        asm volatile("buffer_inv sc1" ::: "memory");
        unsigned nloc = b.st[0], nx = b.st[1];
        if (nloc == 0u) { xcd_barrier_complete(bar, b.x, nloc, nx); b.st[0] = nloc; b.st[1] = nx; }
        const unsigned old = xb_add(&bar[XB_XSUB(b.x)], 1u);
        const unsigned gen = old / nloc;
        if (old - gen * nloc == (nloc >> 1)) asm volatile("buffer_wbl2 sc1" ::: "memory");
        if (old + 1u == (gen + 1u) * nloc) {
            __builtin_amdgcn_fence(__ATOMIC_RELEASE, "agent");
            asm volatile("s_waitcnt vmcnt(0)" ::: "memory");
            const unsigned og = xb_add(&bar[XB_TOP], 1u);
            const unsigned tg = og / nx;
            if (og + 1u == (tg + 1u) * nx) xb_add(&bar[XB_TOPGEN], 1u);
            else XB_SPIN(xb_ld(&bar[XB_TOPGEN]) == tg, bar);
            asm volatile("" ::: "memory");
            xb_add(&bar[XB_XGEN(b.x)], 1u);
            asm volatile("s_waitcnt vmcnt(0)" ::: "memory");
        } else {
            XB_SPIN(xb_ld(&bar[XB_XGEN(b.x)]) == gen, bar);
            asm volatile("" ::: "memory");
            asm volatile("s_waitcnt vmcnt(0)" ::: "memory");
        }
    }
    __syncthreads();
}
constexpr int NWAVES = 8, NTHR = 512;
constexpr int BATCH = 16, SEQ = 2048, D = 1024, M = BATCH * SEQ, DFF = 2816, NUP = 2 * DFF, MEMLEN = 256, MROWS = BATCH * MEMLEN, DEPTH = 2;
constexpr int NIN = 3072;
constexpr int C_HQ = 0, C_HF = 256, C_HI = 512, C_HG = 768, C_GQ = 1024, C_GK = 1152, C_GV = 1280, C_GR = 1536, C_DQ = 1792, C_DK = 2048, C_DV = 2304, C_CA = 2560, C_CG = 2816;
constexpr float EPS = 1e-6f, LOG2E = 1.4426950408889634f;

constexpr size_t MiB = 1u << 20;
constexpr size_t WS_CTL = 0, CTL_ZERO_BYTES = 32 * 1024;
constexpr size_t WS_SSQ = 1 * MiB;
constexpr size_t SZ_W1 = (size_t)NUP * D * 2, SZ_W2 = (size_t)D * DFF * 2, SZ_WIN = (size_t)NIN * D * 2, SZ_SQ = (size_t)D * D * 2;
constexpr size_t WS_W1 = 4 * MiB;
constexpr size_t WS_W2 = WS_W1 + DEPTH * SZ_W1;
constexpr size_t WS_W3 = WS_W2 + DEPTH * SZ_W2;
constexpr size_t WS_W4 = WS_W3 + DEPTH * SZ_W1;
constexpr size_t WS_WIN = WS_W4 + DEPTH * SZ_W2;
constexpr size_t WS_WOUT = WS_WIN + DEPTH * SZ_WIN;
constexpr size_t WS_WQ = WS_WOUT + DEPTH * SZ_SQ;
constexpr size_t WS_WK = WS_WQ + DEPTH * SZ_SQ;
constexpr size_t WS_WV = WS_WK + DEPTH * SZ_SQ;
constexpr size_t WS_WO = WS_WV + DEPTH * SZ_SQ;
constexpr size_t WS_WEND = WS_WO + DEPTH * SZ_SQ;
constexpr size_t WS_MEMN = 104 * MiB;
constexpr size_t WS_KB = WS_MEMN + 16 * MiB;
constexpr size_t WS_VT = WS_KB + 16 * MiB;
constexpr size_t WS_ROPE = WS_VT + 16 * MiB;
constexpr size_t WS_TAB_LB = WS_ROPE + 2 * MiB, WS_TAB_GW = WS_TAB_LB + 4096, WS_WLR = WS_TAB_LB + 65536, WS_LR = WS_TAB_LB + 262144;
constexpr size_t WS_XB = 156 * MiB;
constexpr size_t WS_MIX = WS_XB + 64 * MiB;
constexpr size_t WS_BIG = WS_MIX + 64 * MiB;
constexpr size_t WS_END = WS_BIG + 208 * MiB;
static_assert(WS_WEND <= WS_MEMN && WS_LR + (size_t)M * 16 * 2 <= WS_XB && WS_END <= 512 * MiB && (size_t)M * NIN * 2 <= 208 * MiB, "d_ws map");
constexpr int CW_BAR = 4096;
constexpr int CW_WQ = 16384;

constexpr int RING_BYTES = 131072, XATT_BYTES = 256 * 528, MISC_OFF = 139264 + 320, LDS_BYTES = 147456;
static_assert(XATT_BYTES <= 139264 && MISC_OFF + 256 <= LDS_BYTES, "LDS map");

typedef unsigned short bf16;
typedef unsigned v4u __attribute__((ext_vector_type(4)));
typedef unsigned v2u __attribute__((ext_vector_type(2)));
typedef float f32x4 __attribute__((ext_vector_type(4)));
typedef float f32x16 __attribute__((ext_vector_type(16)));
typedef short bf16x8 __attribute__((ext_vector_type(8)));
typedef short s16x4 __attribute__((ext_vector_type(4)));
typedef unsigned long long u64;
#define LDS_WAIT() asm volatile("s_waitcnt lgkmcnt(0)" ::: "memory")
__device__ __forceinline__ unsigned f2bf(float f) { unsigned u = __builtin_bit_cast(unsigned, f); return (u + 0x7fffu + ((u >> 16) & 1u)) >> 16; }
__device__ __forceinline__ unsigned pk2(float lo, float hi) { return f2bf(lo) | (f2bf(hi) << 16); }
__device__ __forceinline__ float bf2f(unsigned short b) { return __builtin_bit_cast(float, (unsigned)b << 16); }
__device__ __forceinline__ float wave_sum(float v) {
#pragma unroll
    for (int o = 1; o < 64; o <<= 1) v += __shfl_xor(v, o);
    return v;
}
__device__ __forceinline__ float sigmoid_f(float x) { return __builtin_amdgcn_rcpf(1.0f + __builtin_amdgcn_exp2f(-LOG2E * x)); }
__device__ __forceinline__ float silu2(float x) { return x * sigmoid_f(x); }
__device__ __forceinline__ float logsig(float z) { return fminf(z, 0.f) - log1pf(expf(-fabsf(z))); }
__device__ __forceinline__ int crow(int r, int hi) { return (r & 3) + 8 * (r >> 2) + 4 * hi; }

struct Args { const float* in[27]; float* out; unsigned char* ws; };

__device__ __forceinline__ int map_up(int n) { const int pn = n >> 8, j = n & 255; return (j < 128) ? 128 * pn + j : DFF + 128 * pn + (j - 128); }
__device__ __forceinline__ int rope_src(int j) { const int hd = j >> 6, dd = j & 63; const int sd = (dd < 4 || dd >= 12) ? dd : (dd < 8 ? dd + 4 : dd - 4); return hd * 64 + sd; }
__device__ __forceinline__ int map_win(int n) {
    if (n < 512 || (n >= 1024 && n < 1280)) return (n & ~15) + (n & 3) + 4 * ((n >> 3) & 1) + 8 * ((n >> 2) & 1);
    if (n < 1536) return n;
    if (n < 1792) return n + 16;
    if (n < 2048) return 1808 + rope_src(n - 1792);
    if (n < 2304) return 2064 + rope_src(n - 2048);
    return n + 16;
}
template <int MAPK, bool F16>
__device__ __forceinline__ void transpose_item(const float* W, int ldw, int coloff, const float* gain, bf16* WT, int K, LAS float* scr, int kb, int nb, int lane) {
    const int k0 = 64 * kb, n0 = 64 * nb; const int n = n0 + lane;
    const int src = (MAPK == 0) ? n : (MAPK == 1 ? map_up(n) : map_win(n));
    const float* wp = W + (size_t)k0 * ldw + coloff + src;
#pragma unroll 1
    for (int h = 0; h < 2; ++h) { float v[32];
#pragma unroll
        for (int i = 0; i < 32; ++i) v[i] = __builtin_nontemporal_load(&wp[(size_t)(32 * h + i) * ldw]);
        if (gain) {
#pragma unroll
            for (int i = 0; i < 32; ++i) v[i] *= gain[k0 + 32 * h + i]; }
#pragma unroll
        for (int i = 0; i < 32; ++i) { const int kk = 32 * h + i; scr[kk * 64 + (lane ^ (kk & 31))] = v[i]; } }
    LDS_WAIT(); asm volatile("" ::: "memory");
    const int c = lane & 7;
#pragma unroll
    for (int j = 0; j < 8; ++j) { const int nn = (lane >> 3) + 8 * j; float x[8];
#pragma unroll
        for (int i = 0; i < 8; ++i) { const int kk = 8 * c + i; x[i] = scr[kk * 64 + (nn ^ (kk & 31))]; }
        v4u o;
        if (F16) { o.x = pg8::cvtpk_h(x[0], x[1]); o.y = pg8::cvtpk_h(x[2], x[3]); o.z = pg8::cvtpk_h(x[4], x[5]); o.w = pg8::cvtpk_h(x[6], x[7]); }
        else { o.x = pk2(x[0], x[1]); o.y = pk2(x[2], x[3]); o.z = pk2(x[4], x[5]); o.w = pk2(x[6], x[7]); }
        *(v4u*)(WT + (size_t)(n0 + nn) * K + k0 + 8 * c) = o; }
    LDS_WAIT(); asm volatile("" ::: "memory");
}
__device__ __forceinline__ void p0_prologue(const Args& A, LAS unsigned char* L, int G) {
    int tid = threadIdx.x; asm volatile("" : "+v"(tid));
    const int lane = tid & 63, wave = __builtin_amdgcn_readfirstlane(tid >> 6);
    unsigned char* ws = A.ws;
    LAS float* scr = (LAS float*)(L + wave * 16384);
    const int gw = blockIdx.x * NWAVES + wave, NGW = G * NWAVES;
    {   v4u* zp = (v4u*)(ws + WS_SSQ + (size_t)M * 8); const v4u z = (v4u){0u, 0u, 0u, 0u};
        for (int i = blockIdx.x * NTHR + tid; i < 8 * M * 8 / 16; i += G * NTHR) zp[i] = z; }
    constexpr int I_UP = (D / 64) * (NUP / 64), I_DN = (DFF / 64) * (D / 64), I_IN = (D / 64) * (NIN / 64), I_SQ = (D / 64) * (D / 64);
    constexpr int PER_L = 2 * I_UP + 2 * I_DN + I_IN + 5 * I_SQ;
    for (int it = gw; it < DEPTH * PER_L; it += NGW) {
        const int l = it / PER_L; int r = it % PER_L;
        if (r < I_UP) { transpose_item<1, true>(A.in[5] + (size_t)l * D * NUP, NUP, 0, A.in[4] + l * D, (bf16*)(ws + WS_W1 + l * SZ_W1), D, scr, r / (NUP / 64), r % (NUP / 64), lane); continue; } r -= I_UP;
        if (r < I_UP) { transpose_item<1, true>(A.in[24] + (size_t)l * D * NUP, NUP, 0, A.in[23] + l * D, (bf16*)(ws + WS_W3 + l * SZ_W1), D, scr, r / (NUP / 64), r % (NUP / 64), lane); continue; } r -= I_UP;
        if (r < I_DN) { transpose_item<0, false>(A.in[6] + (size_t)l * DFF * D, D, 0, nullptr, (bf16*)(ws + WS_W2 + l * SZ_W2), DFF, scr, r / (D / 64), r % (D / 64), lane); continue; } r -= I_DN;
        if (r < I_DN) { transpose_item<0, false>(A.in[25] + (size_t)l * DFF * D, D, 0, nullptr, (bf16*)(ws + WS_W4 + l * SZ_W2), DFF, scr, r / (D / 64), r % (D / 64), lane); continue; } r -= I_DN;
        if (r < I_IN) { transpose_item<2, true>(A.in[8] + (size_t)l * D * 3088, 3088, 0, A.in[7] + l * D, (bf16*)(ws + WS_WIN + l * SZ_WIN), D, scr, r / (NIN / 64), r % (NIN / 64), lane); continue; } r -= I_IN;
        const int which = r / I_SQ, rr = r % I_SQ, kb = rr / (D / 64), nb = rr % (D / 64);
        if (which == 0) transpose_item<0, false>(A.in[17] + (size_t)l * D * D, D, 0, nullptr, (bf16*)(ws + WS_WOUT + l * SZ_SQ), D, scr, kb, nb, lane);
        else if (which == 1) transpose_item<0, true>(A.in[20] + (size_t)l * D * D, D, 0, A.in[18] + l * D, (bf16*)(ws + WS_WQ + l * SZ_SQ), D, scr, kb, nb, lane);
        else if (which == 2) transpose_item<0, false>(A.in[21] + (size_t)l * D * 2 * D, 2 * D, 0, nullptr, (bf16*)(ws + WS_WK + l * SZ_SQ), D, scr, kb, nb, lane);
        else if (which == 3) transpose_item<0, false>(A.in[21] + (size_t)l * D * 2 * D, 2 * D, D, nullptr, (bf16*)(ws + WS_WV + l * SZ_SQ), D, scr, kb, nb, lane);
        else transpose_item<0, false>(A.in[22] + (size_t)l * D * D, D, 0, nullptr, (bf16*)(ws + WS_WO + l * SZ_SQ), D, scr, kb, nb, lane);
    }
    u64* ssq0 = (u64*)(ws + WS_SSQ);
    for (int m = gw; m < M; m += 2 * NGW) {
        const int m2 = m + NGW;
        const f32x4* xr = (const f32x4*)(A.in[0] + (size_t)m * D) + lane; const f32x4* xr2 = (const f32x4*)(A.in[0] + (size_t)(m2 < M ? m2 : m) * D) + lane;
        f32x4 v[4], u[4];
#pragma unroll
        for (int j = 0; j < 4; ++j) { v[j] = __builtin_nontemporal_load(&xr[64 * j]); u[j] = __builtin_nontemporal_load(&xr2[64 * j]); }
        v2u* br = (v2u*)((bf16*)(ws + WS_XB) + (size_t)m * D) + lane; float ss = 0.f, ss2 = 0.f;
#pragma unroll
        for (int j = 0; j < 4; ++j) { v2u w; w.x = pg8::cvtpk_h(v[j][0], v[j][1]); w.y = pg8::cvtpk_h(v[j][2], v[j][3]); br[64 * j] = w; ss += (v[j][0] * v[j][0] + v[j][1] * v[j][1]) + (v[j][2] * v[j][2] + v[j][3] * v[j][3]); }
        ss = wave_sum(ss);
        if (lane == 0) ssq0[m] = (u64)(ss * pg8::SSQ_SCALE + 0.5f);
        if (m2 < M) { v2u* br2 = (v2u*)((bf16*)(ws + WS_XB) + (size_t)m2 * D) + lane;
#pragma unroll
            for (int j = 0; j < 4; ++j) { v2u w; w.x = pg8::cvtpk_h(u[j][0], u[j][1]); w.y = pg8::cvtpk_h(u[j][2], u[j][3]); br2[64 * j] = w; ss2 += (u[j][0] * u[j][0] + u[j][1] * u[j][1]) + (u[j][2] * u[j][2] + u[j][3] * u[j][3]); }
            ss2 = wave_sum(ss2);
            if (lane == 0) ssq0[m2] = (u64)(ss2 * pg8::SSQ_SCALE + 0.5f); }
    }
    for (int mm0 = gw; mm0 < DEPTH * MROWS; mm0 += 2 * NGW) {
        f32x4 v[2][4];
#pragma unroll
        for (int q = 0; q < 2; ++q) { const int mm = mm0 + q * NGW < DEPTH * MROWS ? mm0 + q * NGW : mm0; const f32x4* xr = (const f32x4*)(A.in[1] + (size_t)(mm % MROWS) * D) + lane;
#pragma unroll
            for (int j = 0; j < 4; ++j) v[q][j] = xr[64 * j]; }
#pragma unroll
        for (int q = 0; q < 2; ++q) { const int mm = mm0 + q * NGW; if (mm >= DEPTH * MROWS) break; const int l = mm / MROWS;
            const f32x4* gr = (const f32x4*)(A.in[19] + (size_t)l * D) + lane; v2u* br = (v2u*)((bf16*)(ws + WS_MEMN) + (size_t)mm * D) + lane; float ss = 0.f;
#pragma unroll
            for (int j = 0; j < 4; ++j) ss += (v[q][j][0] * v[q][j][0] + v[q][j][1] * v[q][j][1]) + (v[q][j][2] * v[q][j][2] + v[q][j][3] * v[q][j][3]);
            const float rs = 1.0f / sqrtf(wave_sum(ss) * (1.0f / D) + EPS);
#pragma unroll
            for (int j = 0; j < 4; ++j) { const f32x4 g = gr[64 * j]; v2u w; w.x = pk2(v[q][j][0] * rs * g[0], v[q][j][1] * rs * g[1]); w.y = pk2(v[q][j][2] * rs * g[2], v[q][j][3] * rs * g[3]); br[64 * j] = w; } }
    }
    for (int e = blockIdx.x * NTHR + tid; e < DEPTH * 256; e += G * NTHR) { const int ch = e & 255; const float a0 = A.in[3][ch], a1 = A.in[3][256 + ch]; const float mx = fmaxf(a0, a1);
        const float e0 = expf(a0 - mx), e1 = expf(a1 - mx); ((float*)(ws + WS_TAB_LB))[e] = (e < 256) ? 0.f : e1 / (e0 + e1); }
    for (int e = blockIdx.x * NTHR + tid; e < DEPTH * 128 * 16; e += G * NTHR) { const int l = e / 2048, ch = (e >> 4) & 127, r = e & 15; ((bf16*)(ws + WS_TAB_GW))[e] = (bf16)f2bf(A.in[10][(size_t)l * 2048 + r * 128 + ch]); }
    for (int e = blockIdx.x * NTHR + tid; e < DEPTH * 16 * D; e += G * NTHR) { const int l = e / (16 * D), r = (e / D) & 15, k = e % D;
        ((_Float16*)(ws + WS_WLR))[e] = (_Float16)(A.in[8][(size_t)l * D * 3088 + (size_t)k * 3088 + 1536 + r] * A.in[7][l * D + k]); }
    {
        float* cs = (float*)(ws + WS_ROPE); float* sn = cs + (size_t)M * 8; const int* pos = (const int*)A.in[2];
        for (int e = blockIdx.x * NTHR + tid; e < M * 8; e += G * NTHR) {
            const int row = e >> 3, i = e & 7;
            const float inv = powf(500000.0f, -(float)(2 * i) / 16.0f);
            const float ang = (float)pos[row] * inv; float s, c; sincosf(ang, &s, &c);
            cs[e] = c; sn[e] = s;
        }
    }
}

__device__ __forceinline__ void conv_unit(const Args& A, int l, int unit, LAS unsigned char* L) {
    int tid = threadIdx.x; asm volatile("" : "+v"(tid));
    const bf16* P = (const bf16*)(A.ws + WS_BIG); bf16* MIX = (bf16*)(A.ws + WS_MIX);
    LAS float* uu = (LAS float*)L;
    LAS float* yy = uu + 62 * 256;
    const int b = unit >> 6, t0 = (unit & 63) * 32; const size_t rowbase = (size_t)b * SEQ;
    v4u avr[4], gvr[4];
#pragma unroll
    for (int it = 0; it < 4; ++it) { const int e = tid + NTHR * it, i = e >> 5, c8 = (e & 31) * 8, t = t0 - 30 + i; avr[it] = (v4u){0u, 0u, 0u, 0u}; gvr[it] = avr[it];
        if (e < 62 * 32 && t >= 0) { avr[it] = *(const v4u*)(P + (rowbase + t) * NIN + C_CA + c8); gvr[it] = *(const v4u*)(P + (rowbase + t) * NIN + C_CG + c8); } }
#pragma unroll
    for (int it = 0; it < 4; ++it) { const int e = tid + NTHR * it; if (e >= 62 * 32) break; const int i = e >> 5, c8 = (e & 31) * 8; const int t = t0 - 30 + i;
        f32x4 u0 = (f32x4){0.f, 0.f, 0.f, 0.f}, u1 = u0;
        if (t >= 0) { const v4u av = avr[it], gv = gvr[it];
            const unsigned aw[4] = {av.x, av.y, av.z, av.w}, gw[4] = {gv.x, gv.y, gv.z, gv.w};
#pragma unroll
            for (int k = 0; k < 4; ++k) { const float a0 = bf2f((unsigned short)(aw[k] & 0xffff)), a1 = bf2f((unsigned short)(aw[k] >> 16)), g0 = bf2f((unsigned short)(gw[k] & 0xffff)), g1 = bf2f((unsigned short)(gw[k] >> 16));
                const float r0 = a0 * sigmoid_f(g0), r1 = a1 * sigmoid_f(g1);
                if (k < 2) { u0[2 * k] = r0; u0[2 * k + 1] = r1; } else { u1[2 * (k - 2)] = r0; u1[2 * (k - 2) + 1] = r1; } } }
        *(LAS f32x4*)(uu + i * 256 + c8) = u0; *(LAS f32x4*)(uu + i * 256 + c8 + 4) = u1; }
    const int c = tid & 255, th = tid >> 8;
    float w[31];
#pragma unroll
    for (int j = 0; j < 31; ++j) w[j] = A.in[13][(size_t)l * 31 * 256 + j * 256 + c];
    const float cb = A.in[14][l * 256 + c];
    __syncthreads();
#pragma unroll 2
    for (int g = 0; g < 4; ++g) { const int tb = 16 * th + 4 * g; const LAS float* up = uu + tb * 256 + c;
        float win[34];
#pragma unroll
        for (int i = 0; i < 34; ++i) win[i] = up[i * 256];
        float y0 = cb, y1 = cb, y2 = cb, y3 = cb;
#pragma unroll
        for (int j = 0; j < 31; ++j) { y0 += w[j] * win[j]; y1 += w[j] * win[j + 1]; y2 += w[j] * win[j + 2]; y3 += w[j] * win[j + 3]; }
        LAS float* yp = yy + tb * 256 + c; yp[0] = y0; yp[256] = y1; yp[512] = y2; yp[768] = y3; }
    __syncthreads();
    const int wave = tid >> 6, lane = tid & 63;
    const f32x4 g4 = *(const f32x4*)(A.in[15] + l * 256 + 4 * lane), b4 = *(const f32x4*)(A.in[16] + l * 256 + 4 * lane);
#pragma unroll
    for (int i = 0; i < 4; ++i) { const int t = wave * 4 + i; const f32x4 yv = *(const LAS f32x4*)(yy + t * 256 + 4 * lane);
        const float mu = wave_sum((yv[0] + yv[1]) + (yv[2] + yv[3])) * (1.0f / 256.0f); const f32x4 dv = yv - mu;
        const float var = wave_sum((dv[0] * dv[0] + dv[1] * dv[1]) + (dv[2] * dv[2] + dv[3] * dv[3])) * (1.0f / 256.0f); const float rs = 1.0f / sqrtf(var + EPS);
        const f32x4 yn = dv * rs * g4 + b4;
        v2u o; o.x = pk2(silu2(yn[0]), silu2(yn[1])); o.y = pk2(silu2(yn[2]), silu2(yn[3]));
        *(v2u*)(MIX + (rowbase + t0 + t) * D + 768 + 4 * lane) = o; }
    __syncthreads();
}

__device__ __forceinline__ float dbias(int d) {
    const unsigned ud = (unsigned)d; const int c = (int)(ud <= 128u) + (int)((ud <= 512u) & ((d & 3) == 0)) + (int)((d >= 0) & ((d & 15) == 0));
    return __builtin_amdgcn_logf((float)c);
}
__device__ __forceinline__ s16x4 vtr(const LAS unsigned char* p) { typedef short v4i16_t __attribute__((ext_vector_type(4))); return __builtin_bit_cast(s16x4, __builtin_amdgcn_ds_read_tr16_b64_v4i16((LAS v4i16_t*)p)); }
__device__ __forceinline__ float swapmax(float m) { return fmaxf(m, __shfl_xor(m, 32)); }
__device__ __forceinline__ float swapsum(float m) { return m + __shfl_xor(m, 32); }
constexpr size_t SCAN_U_HG = 0, SCAN_U_GL = (size_t)64 * 32 * 64 * 64 * 4, SCAN_D_HG = SCAN_U_GL + (size_t)64 * 32 * 64 * 32 * 4, SCAN_D_GL = SCAN_D_HG + (size_t)64 * 32 * 64 * 4;
constexpr size_t SCAN_S_OFF = 56 * MiB;
static_assert(SCAN_D_GL + (size_t)64 * 32 * 32 * 4 <= SCAN_S_OFF && SCAN_S_OFF + SCAN_D_HG <= (size_t)M * D * 4, "scan scratch fits d_out");

#define DPP_ADD(v, ctrl, rmask, bc) v += __builtin_bit_cast(float, __builtin_amdgcn_update_dpp(0, __builtin_bit_cast(int, v), ctrl, rmask, 0xF, bc))
__device__ __forceinline__ float scan32(float v) {
    DPP_ADD(v, 0x111, 0xF, true); DPP_ADD(v, 0x112, 0xF, true); DPP_ADD(v, 0x114, 0xF, true); DPP_ADD(v, 0x118, 0xF, true);
    DPP_ADD(v, 0x142, 0xA, false);
    return v;
}
__device__ __forceinline__ float bcast31(float v, int lane) { return __builtin_bit_cast(float, __builtin_amdgcn_ds_bpermute((31 + (lane & 32)) << 2, __builtin_bit_cast(int, v))); }
__device__ __forceinline__ float fexp2(float x) { return __builtin_amdgcn_exp2f(x); }
__device__ __forceinline__ float flog2(float x) { return __builtin_amdgcn_logf(x); }
__device__ __forceinline__ bf16x8 pack8(const float (&x)[8]) { v4u w = (v4u){pg8::cvtpk(x[0], x[1]), pg8::cvtpk(x[2], x[3]), pg8::cvtpk(x[4], x[5]), pg8::cvtpk(x[6], x[7])}; return __builtin_bit_cast(bf16x8, w); }
struct Raw8 { v2u a, b; };
__device__ __forceinline__ Raw8 ldraw(const bf16* rowp, int s, int hi) { const v4u t = *(const v4u*)(rowp + 16 * s + 8 * hi); Raw8 r; r.a = (v2u){t.x, t.y}; r.b = (v2u){t.z, t.w}; return r; }
__device__ __forceinline__ void unpack8(const Raw8& r, float (&x)[8]) {
    x[0] = bf2f((unsigned short)(r.a.x & 0xffff)); x[1] = bf2f((unsigned short)(r.a.x >> 16)); x[2] = bf2f((unsigned short)(r.a.y & 0xffff)); x[3] = bf2f((unsigned short)(r.a.y >> 16));
    x[4] = bf2f((unsigned short)(r.b.x & 0xffff)); x[5] = bf2f((unsigned short)(r.b.x >> 16)); x[6] = bf2f((unsigned short)(r.b.y & 0xffff)); x[7] = bf2f((unsigned short)(r.b.y >> 16));
}
__device__ __forceinline__ void ld8(const bf16* rowp, int s, int hi, float (&x)[8]) {
    const v2u a = *(const v2u*)(rowp + 16 * s + 4 * hi), b = *(const v2u*)(rowp + 16 * s + 8 + 4 * hi);
    x[0] = bf2f((unsigned short)(a.x & 0xffff)); x[1] = bf2f((unsigned short)(a.x >> 16)); x[2] = bf2f((unsigned short)(a.y & 0xffff)); x[3] = bf2f((unsigned short)(a.y >> 16));
    x[4] = bf2f((unsigned short)(b.x & 0xffff)); x[5] = bf2f((unsigned short)(b.x >> 16)); x[6] = bf2f((unsigned short)(b.y & 0xffff)); x[7] = bf2f((unsigned short)(b.y >> 16));
}
__device__ __forceinline__ int img_off(int row, int col) { return (((col >> 5) * 4 + (row >> 4)) << 10) + ((row & 15) << 6) + ((col & 31) << 1); }
__device__ __forceinline__ bf16x8 tr_frag(const LAS unsigned char* img, int colhalf, int rowgroup, int lane) {
    const LAS unsigned char* p = img + ((colhalf * 4 + rowgroup) << 10) + ((lane >> 4) & 1) * 32 + (lane & 3) * 8 + (4 * (lane >> 5) + ((lane & 15) >> 2)) * 64;
    const s16x4 a = vtr(p), b = vtr(p + 512);
    return (bf16x8){a[0], a[1], a[2], a[3], b[0], b[1], b[2], b[3]};
}
__device__ __forceinline__ bf16x8 tr_frag_p(const LAS unsigned char* img, int colhalf, int rowgroup, int lane) {
    const LAS unsigned char* p = img + ((colhalf * 4 + rowgroup) << 10) + (lane & 1) * 32 + ((lane >> 4) & 1) * 16 + ((lane >> 1) & 1) * 8 + (4 * (lane >> 5) + ((lane & 15) >> 2)) * 64;
    const s16x4 a = vtr(p), b = vtr(p + 512);
    return (bf16x8){a[0], a[1], a[2], a[3], b[0], b[1], b[2], b[3]};
}
template <int DK, bool HG>
__device__ __forceinline__ void scan_gates(const Raw8& zk, const f32x4& c0, const f32x4& c1, int s, const f32x16& acc, float (&lg2)[8], float (&kv)[8]) {
    float z[8]; unpack8(zk, z);
    if (HG) {
#pragma unroll
        for (int j = 0; j < 8; ++j) { const float lb = j < 4 ? c0[j & 3] : c1[j & 3]; const float e = fexp2(-LOG2E * fmaxf(z[j], -80.f)); const float sg = __builtin_amdgcn_rcpf(1.0f + e);
            const float f = lb + (1.0f - lb) * sg; lg2[j] = flog2(fmaxf(f, 1e-30f)); kv[j] = (1.0f - lb) * (e * sg); }
    } else {
#pragma unroll
        for (int j = 0; j < 8; ++j) { const float lo = acc[8 * s + j] + (j < 4 ? c0[j & 3] : c1[j & 3]); const float e = fexp2(-LOG2E * fmaxf(lo, -80.f));
            lg2[j] = -flog2(1.0f + e) * (1.0f / 16.0f); kv[j] = z[j]; }
    }
}
__device__ __forceinline__ bf16x8 gla_gw(const Args& A, int l, int h, int hi, int lane) {
    return *(const bf16x8*)((const bf16*)(A.ws + WS_TAB_GW) + (size_t)l * 128 * 16 + (h * 32 + (lane & 31)) * 16 + 8 * hi); }
__device__ __forceinline__ f32x16 gla_logits(const bf16x8& af, const bf16x8& lrf) {
    f32x16 acc;
#pragma unroll
    for (int r = 0; r < 16; ++r) acc[r] = 0.f;
    return __builtin_amdgcn_mfma_f32_32x32x16_bf16(af, lrf, acc, 0, 0, 0);
}
template <bool HG> __device__ __forceinline__ const float* scan_cptr(const Args& A, int l, int h) { return HG ? ((const float*)(A.ws + WS_TAB_LB) + l * 256 + h * 64) : (A.in[11] + l * 128 + h * 32); }

template <int DK, bool HG>
__device__ __forceinline__ void scan_taskA(const Args& A, int l, int seq, int chunk, LAS unsigned char* WL) {
    constexpr int KS = DK / 16, CB = DK / 32;
    int lane = threadIdx.x & 63; asm volatile("" : "+v"(lane));
    const int r32 = lane & 31, hi = lane >> 5, b = seq >> 2, h = seq & 3;
    const bf16* P = (const bf16*)(A.ws + WS_BIG);
    const size_t row0 = (size_t)b * SEQ + chunk * 64;
    LAS unsigned char* kimg = WL; LAS unsigned char* vimg = WL + 8192;
    const int cv = HG ? (C_HI + h * 64) : (C_GV + h * 64), czk = HG ? (C_HF + h * 64) : (C_GK + h * 32);
    const bf16* rp0 = P + (row0 + r32) * NIN; const bf16* rp1 = P + (row0 + 32 + r32) * NIN;
    v4u vraw[8];
#pragma unroll
    for (int w = 0; w < 8; ++w) vraw[w] = *(const v4u*)(P + (row0 + 16 * (w & 3) + (lane >> 2)) * NIN + cv + (w >> 2) * 32 + (lane & 3) * 8);
    Raw8 zk[2][KS]; f32x4 cc[KS][2]; const float* cp = scan_cptr<HG>(A, l, h);
#pragma unroll
    for (int s = 0; s < KS; ++s) { zk[0][s] = ldraw(rp0 + czk, s, hi); zk[1][s] = ldraw(rp1 + czk, s, hi); cc[s][0] = *(const f32x4*)(cp + 16 * s + 4 * hi); cc[s][1] = *(const f32x4*)(cp + 16 * s + 8 + 4 * hi); }
    f32x16 lg0, lg1;
#pragma unroll
    for (int r = 0; r < 16; ++r) { lg0[r] = 0.f; lg1[r] = 0.f; }
    if (!HG) { const bf16x8 af = gla_gw(A, l, h, hi, lane), l0 = *(const bf16x8*)((const bf16*)(A.ws + WS_LR) + (row0 + r32) * 16 + 8 * hi), l1 = *(const bf16x8*)((const bf16*)(A.ws + WS_LR) + (row0 + 32 + r32) * 16 + 8 * hi); lg0 = gla_logits(af, l0); lg1 = gla_logits(af, l1); }
#pragma unroll
    for (int w = 0; w < 8; ++w) *(LAS v4u*)(vimg + w * 1024 + lane * 16) = vraw[w];
    __builtin_amdgcn_s_barrier();
    float* dv = (float*)((unsigned char*)A.out + (HG ? SCAN_D_HG : SCAN_D_GL)) + ((size_t)(seq & 63) * 32 + chunk) * DK;
#pragma unroll
    for (int s = 0; s < KS; ++s) { float b0[8], b1[8], k0[8], k1[8];
        scan_gates<DK, HG>(zk[0][s], cc[s][0], cc[s][1], s, lg0, b0, k0); scan_gates<DK, HG>(zk[1][s], cc[s][0], cc[s][1], s, lg1, b1, k1);
#pragma unroll
        for (int j = 0; j < 8; ++j) { b0[j] = scan32(b0[j]); b1[j] = scan32(b1[j]); }
        float ed[8];
#pragma unroll
        for (int j = 0; j < 8; ++j) { const float t0 = bcast31(b0[j], lane); b1[j] += t0; const float bl = bcast31(b1[j], lane);
            k0[j] *= fexp2(bl - b0[j]); k1[j] *= fexp2(bl - b1[j]); ed[j] = fexp2(bl); }
        if (r32 == 31) { *(f32x4*)(dv + 16 * s + 4 * hi) = (f32x4){ed[0], ed[1], ed[2], ed[3]}; *(f32x4*)(dv + 16 * s + 8 + 4 * hi) = (f32x4){ed[4], ed[5], ed[6], ed[7]}; }
        const int c0 = 16 * s + 4 * hi;
        *(LAS v2u*)(kimg + img_off(r32, c0)) = (v2u){pg8::cvtpk(k0[0], k0[1]), pg8::cvtpk(k0[2], k0[3])}; *(LAS v2u*)(kimg + img_off(r32, c0 + 8)) = (v2u){pg8::cvtpk(k0[4], k0[5]), pg8::cvtpk(k0[6], k0[7])};
        *(LAS v2u*)(kimg + img_off(32 + r32, c0)) = (v2u){pg8::cvtpk(k1[0], k1[1]), pg8::cvtpk(k1[2], k1[3])}; *(LAS v2u*)(kimg + img_off(32 + r32, c0 + 8)) = (v2u){pg8::cvtpk(k1[4], k1[5]), pg8::cvtpk(k1[6], k1[7])}; }
    asm volatile("s_waitcnt lgkmcnt(0)" ::: "memory");
    __builtin_amdgcn_s_barrier();
    float* UT = (float*)((unsigned char*)A.out + (HG ? SCAN_U_HG : SCAN_U_GL)) + ((size_t)(seq & 63) * 32 + chunk) * 64 * DK;
#pragma unroll
    for (int vb = 0; vb < 2; ++vb)
#pragma unroll
        for (int cb = 0; cb < CB; ++cb) { f32x16 acc;
#pragma unroll
            for (int r = 0; r < 16; ++r) acc[r] = 0.f;
#pragma unroll
            for (int tg = 0; tg < 4; ++tg) acc = __builtin_amdgcn_mfma_f32_32x32x16_bf16(tr_frag_p(kimg, cb, tg, lane), tr_frag(vimg, vb, tg, lane), acc, 0, 0, 0);
#pragma unroll
            for (int g = 0; g < 4; ++g) *(f32x4*)(UT + (size_t)(32 * vb + r32) * DK + 32 * cb + 16 * hi + 4 * g) = (f32x4){acc[4 * g], acc[4 * g + 1], acc[4 * g + 2], acc[4 * g + 3]}; }
}

__device__ __forceinline__ void scan_phaseB(const Args& A, int G) {
    const int nit = G == 256 ? 1 : (192 + G - 1) / G;
    for (int it = 0; it < nit; ++it) {
        int E; if (G == 256) { if (threadIdx.x >= 384) break; E = blockIdx.x * 384 + threadIdx.x; } else { const int w = blockIdx.x + it * G; if (w >= 192) break; E = w * NTHR + threadIdx.x; }
        const bool hg = E < 65536; const int DKc = hg ? 64 : 32; const int e = hg ? E : E - 65536;
        const int per = 64 * DKc / 4, seq = e / per, rem = e % per, v = rem / (DKc / 4), c4 = rem % (DKc / 4);
        float* U = (float*)((unsigned char*)A.out + (hg ? SCAN_U_HG : SCAN_U_GL)) + (size_t)seq * 32 * 64 * DKc + (size_t)v * DKc + 4 * c4;
        const float* dv = (const float*)((unsigned char*)A.out + (hg ? SCAN_D_HG : SCAN_D_GL)) + (size_t)seq * 32 * DKc + 4 * c4;
        f32x4 S = (f32x4){0.f, 0.f, 0.f, 0.f};
#pragma unroll 1
        for (int c0 = 0; c0 < 32; c0 += 16) { f32x4 u[16], d[16];
#pragma unroll
            for (int i = 0; i < 16; ++i) { u[i] = *(const f32x4*)(U + (size_t)(c0 + i) * 64 * DKc); d[i] = *(const f32x4*)(dv + (size_t)(c0 + i) * DKc); }
#pragma unroll
            for (int i = 0; i < 16; ++i) { *(f32x4*)((unsigned char*)(U + (size_t)(c0 + i) * 64 * DKc) + SCAN_S_OFF) = S; S = d[i] * S + u[i]; } }
    }
}

template <int DK, bool HG>
__device__ __forceinline__ void scan_taskC(const Args& A, int l, int seq, int chunk, LAS unsigned char* WL) {
    constexpr int KS = DK / 16;
    int lane = threadIdx.x & 63; asm volatile("" : "+v"(lane));
    const int r32 = lane & 31, hi = lane >> 5, b = seq >> 2, h = seq & 3;
    const int pr32 = 16 * ((r32 >> 2) & 1) + 4 * (r32 >> 3) + (r32 & 3);
    const bf16* P = (const bf16*)(A.ws + WS_BIG); bf16* MIX = (bf16*)(A.ws + WS_MIX);
    const size_t row0 = (size_t)b * SEQ + chunk * 64;
    LAS unsigned char* vimg = WL;
    const int cq = HG ? (C_HQ + h * 64) : (C_GQ + h * 32), cv = HG ? (C_HI + h * 64) : (C_GV + h * 64), cg = HG ? (C_HG + h * 64) : (C_GR + h * 64);
    const int czk = HG ? (C_HF + h * 64) : (C_GK + h * 32);
    const bf16* rp0 = P + (row0 + r32) * NIN; const bf16* rp1 = P + (row0 + 32 + r32) * NIN;
    v4u vraw[8];
#pragma unroll
    for (int w = 0; w < 8; ++w) vraw[w] = *(const v4u*)(P + (row0 + 16 * (w & 3) + (lane >> 2)) * NIN + cv + (w >> 2) * 32 + (lane & 3) * 8);
    Raw8 zk[2][KS], qq[2][KS]; f32x4 cc[KS][2]; const float* cp = scan_cptr<HG>(A, l, h);
#pragma unroll
    for (int s = 0; s < KS; ++s) { zk[0][s] = ldraw(rp0 + czk, s, hi); zk[1][s] = ldraw(rp1 + czk, s, hi); qq[0][s] = ldraw(rp0 + cq, s, hi); qq[1][s] = ldraw(rp1 + cq, s, hi);
        cc[s][0] = *(const f32x4*)(cp + 16 * s + 4 * hi); cc[s][1] = *(const f32x4*)(cp + 16 * s + 8 + 4 * hi); }
    f32x16 lg0, lg1;
#pragma unroll
    for (int r = 0; r < 16; ++r) { lg0[r] = 0.f; lg1[r] = 0.f; }
    if (!HG) { const bf16x8 af = gla_gw(A, l, h, hi, lane), l0 = *(const bf16x8*)((const bf16*)(A.ws + WS_LR) + (row0 + r32) * 16 + 8 * hi), l1 = *(const bf16x8*)((const bf16*)(A.ws + WS_LR) + (row0 + 32 + r32) * 16 + 8 * hi); lg0 = gla_logits(af, l0); lg1 = gla_logits(af, l1); }
#pragma unroll
    for (int w = 0; w < 8; ++w) *(LAS v4u*)(vimg + w * 1024 + lane * 16) = vraw[w];
    __builtin_amdgcn_s_barrier();
    const float qsc = HG ? 1.0f : 0.17677669529663687f;
    bf16x8 qh[2][KS], qt1[KS], k0[KS], k1[2][KS];
    {
#pragma unroll
        for (int s = 0; s < KS; ++s) { float b0[8], b1[8], kk0[8], kk1[8], q0[8], q1[8], x[8], B1[8];
            scan_gates<DK, HG>(zk[0][s], cc[s][0], cc[s][1], s, lg0, b0, kk0); scan_gates<DK, HG>(zk[1][s], cc[s][0], cc[s][1], s, lg1, b1, kk1);
            unpack8(qq[0][s], q0); unpack8(qq[1][s], q1);
#pragma unroll
            for (int j = 0; j < 8; ++j) { b0[j] = scan32(b0[j]); b1[j] = scan32(b1[j]); }
#pragma unroll
            for (int j = 0; j < 8; ++j) B1[j] = bcast31(b0[j], lane);
#pragma unroll
            for (int j = 0; j < 8; ++j) x[j] = q0[j] * qsc * fexp2(b0[j]);
            qh[0][s] = pack8(x);
#pragma unroll
            for (int j = 0; j < 8; ++j) x[j] = q1[j] * qsc * fexp2(b1[j]);
            qh[1][s] = pack8(x);
#pragma unroll
            for (int j = 0; j < 8; ++j) x[j] = q1[j] * qsc * fexp2(b1[j] + B1[j]);
            qt1[s] = pack8(x);
#pragma unroll
            for (int j = 0; j < 8; ++j) x[j] = kk0[j] * fexp2(fminf(-b0[j], 120.f));
            k0[s] = pack8(x);
#pragma unroll
            for (int j = 0; j < 8; ++j) x[j] = kk0[j] * fexp2(B1[j] - b0[j]);
            k1[0][s] = pack8(x);
#pragma unroll
            for (int j = 0; j < 8; ++j) x[j] = kk1[j] * fexp2(fminf(-b1[j], 120.f));
            k1[1][s] = pack8(x); }
    }
    __builtin_amdgcn_s_barrier();
    const float* ST = (const float*)((unsigned char*)A.out + SCAN_S_OFF + (HG ? SCAN_U_HG : SCAN_U_GL)) + ((size_t)(seq & 63) * 32 + chunk) * 64 * DK;
    f32x4 st[2][KS][2];
#pragma unroll
    for (int s = 0; s < KS; ++s) { const float* sp = ST + (size_t)pr32 * DK + 16 * s + 4 * hi; st[0][s][0] = *(const f32x4*)sp; st[0][s][1] = *(const f32x4*)(sp + 8); }
    asm volatile("s_waitcnt lgkmcnt(0)" ::: "memory");
    f32x16 x00, x01, x11;
#pragma unroll
    for (int r = 0; r < 16; ++r) { x00[r] = 0.f; x01[r] = 0.f; x11[r] = 0.f; }
#pragma unroll
    for (int s = 0; s < KS; ++s) { x00 = __builtin_amdgcn_mfma_f32_32x32x16_bf16(k0[s], qh[0][s], x00, 0, 0, 0); x01 = __builtin_amdgcn_mfma_f32_32x32x16_bf16(k1[0][s], qh[1][s], x01, 0, 0, 0);
        x11 = __builtin_amdgcn_mfma_f32_32x32x16_bf16(k1[1][s], qh[1][s], x11, 0, 0, 0); }
    __builtin_amdgcn_s_barrier();
    asm volatile("" ::: "memory");
#pragma unroll
    for (int s = 0; s < KS; ++s) { const float* sp = ST + (size_t)(32 + pr32) * DK + 16 * s + 4 * hi; st[1][s][0] = *(const f32x4*)sp; st[1][s][1] = *(const f32x4*)(sp + 8); }
    const float* og = (HG ? A.in[9] : A.in[12]) + l * 256 + h * 64;
    v4u graw[2][2][2];
#pragma unroll
    for (int vb = 0; vb < 2; ++vb)
#pragma unroll
        for (int g = 0; g < 2; ++g) { const int v0 = 32 * vb + 16 * hi + 8 * g; graw[0][vb][g] = *(const v4u*)(rp0 + cg + v0); graw[1][vb][g] = *(const v4u*)(rp1 + cg + v0); }
#pragma unroll
    for (int r = 0; r < 16; ++r) { const bool keep = crow(r, hi) <= r32; x00[r] = keep ? x00[r] : 0.f; x11[r] = keep ? x11[r] : 0.f; }
    bf16x8 p00[2], p01[2], p11[2];
#pragma unroll
    for (int k = 0; k < 2; ++k) { float t0[8], t1[8], t2[8];
#pragma unroll
        for (int j = 0; j < 8; ++j) { t0[j] = x00[8 * k + j]; t1[j] = x01[8 * k + j]; t2[j] = x11[8 * k + j]; }
        p00[k] = pack8(t0); p01[k] = pack8(t1); p11[k] = pack8(t2); }
    f32x16 o[2][2];
#pragma unroll
    for (int vb = 0; vb < 2; ++vb) {
#pragma unroll
        for (int r = 0; r < 16; ++r) { o[vb][0][r] = 0.f; o[vb][1][r] = 0.f; }
#pragma unroll
        for (int k = 0; k < 2; ++k) { const bf16x8 v0 = tr_frag_p(vimg, vb, k, lane), v1 = tr_frag_p(vimg, vb, 2 + k, lane);
            o[vb][0] = __builtin_amdgcn_mfma_f32_32x32x16_bf16(v0, p00[k], o[vb][0], 0, 0, 0);
            o[vb][1] = __builtin_amdgcn_mfma_f32_32x32x16_bf16(v0, p01[k], o[vb][1], 0, 0, 0);
            o[vb][1] = __builtin_amdgcn_mfma_f32_32x32x16_bf16(v1, p11[k], o[vb][1], 0, 0, 0); }
#pragma unroll
        for (int s = 0; s < KS; ++s) { const f32x4 a = st[vb][s][0], c = st[vb][s][1];
            const float sx[8] = {a[0], a[1], a[2], a[3], c[0], c[1], c[2], c[3]}; const bf16x8 sf = pack8(sx);
            o[vb][0] = __builtin_amdgcn_mfma_f32_32x32x16_bf16(sf, qh[0][s], o[vb][0], 0, 0, 0);
            o[vb][1] = __builtin_amdgcn_mfma_f32_32x32x16_bf16(sf, qt1[s], o[vb][1], 0, 0, 0); }
    }
    __builtin_amdgcn_s_barrier();
    f32x4 gn[2][4];
#pragma unroll
    for (int vb = 0; vb < 2; ++vb)
#pragma unroll
        for (int g = 0; g < 4; ++g) gn[vb][g] = *(const f32x4*)(og + 32 * vb + 16 * hi + 4 * g);
#pragma unroll
    for (int tb = 0; tb < 2; ++tb) { float ss = 0.f;
#pragma unroll
        for (int vb = 0; vb < 2; ++vb)
#pragma unroll
            for (int r = 0; r < 16; ++r) ss += o[vb][tb][r] * o[vb][tb][r];
        ss += __shfl_xor(ss, 32);
        const float rs = 1.0f / sqrtf(ss * (1.0f / 64.0f) + EPS);
        bf16* orow = MIX + (row0 + 32 * tb + r32) * D + (HG ? 0 : 256) + h * 64;
#pragma unroll
        for (int vb = 0; vb < 2; ++vb)
#pragma unroll
            for (int g = 0; g < 2; ++g) { const int v0 = 32 * vb + 16 * hi + 8 * g; const v4u gg = graw[tb][vb][g]; const f32x4 ga = gn[vb][2 * g], gb = gn[vb][2 * g + 1];
                const float g0 = bf2f((unsigned short)(gg.x & 0xffff)), g1 = bf2f((unsigned short)(gg.x >> 16)), g2 = bf2f((unsigned short)(gg.y & 0xffff)), g3 = bf2f((unsigned short)(gg.y >> 16));
                const float g4 = bf2f((unsigned short)(gg.z & 0xffff)), g5 = bf2f((unsigned short)(gg.z >> 16)), g6 = bf2f((unsigned short)(gg.w & 0xffff)), g7 = bf2f((unsigned short)(gg.w >> 16));
                v4u w; w.x = pk2(o[vb][tb][8 * g] * rs * ga[0] * silu2(g0), o[vb][tb][8 * g + 1] * rs * ga[1] * silu2(g1)); w.y = pk2(o[vb][tb][8 * g + 2] * rs * ga[2] * silu2(g2), o[vb][tb][8 * g + 3] * rs * ga[3] * silu2(g3));
                w.z = pk2(o[vb][tb][8 * g + 4] * rs * gb[0] * silu2(g4), o[vb][tb][8 * g + 5] * rs * gb[1] * silu2(g5)); w.w = pk2(o[vb][tb][8 * g + 6] * rs * gb[2] * silu2(g6), o[vb][tb][8 * g + 7] * rs * gb[3] * silu2(g7));
                *(v4u*)(orow + v0) = w; } }
}

__device__ __forceinline__ void dattn_unit(const Args& A, int unit, LAS unsigned char* L) {
    int tid = threadIdx.x; asm volatile("" : "+v"(tid));
    const bf16* P = (const bf16*)(A.ws + WS_BIG); bf16* MIX = (bf16*)(A.ws + WS_MIX);
    const int lane = tid & 63, r32 = lane & 31, hi = lane >> 5, wid = __builtin_amdgcn_readfirstlane(tid >> 6);
    const int bh = unit >> 3, qb = unit & 7, b = bh >> 2, h = bh & 3; const size_t rowbase = (size_t)b * SEQ; const int q0 = qb * 256;
    const int qw = q0 + wid * 32, qpos = qw + r32;
    const bf16* Qp = P + (rowbase + qpos) * NIN + C_DQ + h * 64;
    bf16x8 qr[4];
#pragma unroll
    for (int d0 = 0; d0 < 4; ++d0) qr[d0] = *(const bf16x8*)(Qp + d0 * 16 + hi * 8);
    const int srow = (tid >> 6) * 8 + (tid & 7), spc = (tid >> 3) & 7;
    const bf16* ksrc = P + (rowbase + srow) * NIN + C_DK + h * 64 + spc * 8;
    const bf16* vsrc = P + (rowbase + srow) * NIN + C_DV + h * 64 + spc * 8;
    const int kdst = spc * 1024 + srow * 16, vdst = 8192 + (((spc >> 2) * 4 + (srow >> 4)) << 10) + ((srow & 15) << 6) + ((spc & 3) << 4);
    const int NT = (q0 + 256) / 64;
    v4u kreg = *(const v4u*)ksrc, vreg = *(const v4u*)vsrc;
    float bfar[16], bmid[16], bnear[16];
#pragma unroll
    for (int r = 0; r < 16; ++r) { const int dm = (qpos - crow(r, hi)) & 15; bfar[r] = dm == 0 ? 0.f : -INFINITY; bmid[r] = dm == 0 ? 1.0f : ((dm & 3) == 0 ? 0.f : -INFINITY);
        bnear[r] = dm == 0 ? 1.5849625007211562f : ((dm & 3) == 0 ? 1.0f : 0.f); }
#define DA_STRADDLE(T_, LO_, HI_) { const int x = qpos - 64 * t - 4 * hi - (T_); \
        _Pragma("unroll") for (int r = 0; r < 16; ++r) { const int off = (r & 3) + 8 * (r >> 2); p0[r] += (x <= off) ? (LO_) : (HI_); p1[r] += (x <= off + 32) ? (LO_) : (HI_); rm = fmaxf(rm, fmaxf(p0[r], p1[r])); } }
    float mrun = -1e30f, lsum = 0.f; f32x16 o0, o1;
#pragma unroll
    for (int r = 0; r < 16; ++r) { o0[r] = 0.f; o1[r] = 0.f; }
    for (int t = 0; t < NT; ++t) {
        LAS unsigned char* buf = L + (t & 1) * 16384;
        *(LAS v4u*)(buf + kdst) = kreg; *(LAS v4u*)(buf + vdst) = vreg;
        if (t + 1 < NT) { kreg = *(const v4u*)(ksrc + (size_t)(t + 1) * 64 * NIN); vreg = *(const v4u*)(vsrc + (size_t)(t + 1) * 64 * NIN); }
        __syncthreads();
        if (64 * t <= qw + 31) {
            const LAS unsigned char* kb = buf + hi * 1024 + r32 * 16;
            f32x16 p0, p1;
#pragma unroll
            for (int r = 0; r < 16; ++r) { p0[r] = 0.f; p1[r] = 0.f; }
#pragma unroll
            for (int d0 = 0; d0 < 4; ++d0) { const bf16x8 b0 = *(const LAS bf16x8*)(kb + d0 * 2048), b1 = *(const LAS bf16x8*)(kb + d0 * 2048 + 512);
                p0 = __builtin_amdgcn_mfma_f32_32x32x16_bf16(b0, qr[d0], p0, 0, 0, 0); p1 = __builtin_amdgcn_mfma_f32_32x32x16_bf16(b1, qr[d0], p1, 0, 0, 0); }
            const int dmin = qw - 64 * t - 63, dmax = qw + 31 - 64 * t;
            float rm = -INFINITY;
            if (dmin > 512) {
#pragma unroll
                for (int r = 0; r < 16; ++r) { p0[r] += bfar[r]; p1[r] += bfar[r]; rm = fmaxf(rm, fmaxf(p0[r], p1[r])); }
            } else if (dmin > 128 && dmax <= 512) {
#pragma unroll
                for (int r = 0; r < 16; ++r) { p0[r] += bmid[r]; p1[r] += bmid[r]; rm = fmaxf(rm, fmaxf(p0[r], p1[r])); }
            } else if (dmin >= 0 && dmax <= 128) {
#pragma unroll
                for (int r = 0; r < 16; ++r) { p0[r] += bnear[r]; p1[r] += bnear[r]; rm = fmaxf(rm, fmaxf(p0[r], p1[r])); }
            } else if (dmin < 0) DA_STRADDLE(-1, -INFINITY, bnear[r])
            else if (dmin <= 128) DA_STRADDLE(128, bnear[r], bmid[r])
            else DA_STRADDLE(512, bmid[r], bfar[r])
            rm = swapmax(rm);
            const float mnew = fmaxf(mrun, rm);
            if (!__all(mnew - mrun <= 8.0f)) {
                const float alpha = __builtin_amdgcn_exp2f(mrun - mnew); mrun = mnew; lsum *= alpha;
#pragma unroll
                for (int r = 0; r < 16; ++r) { o0[r] *= alpha; o1[r] *= alpha; } }
            float rs = 0.f;
#pragma unroll
            for (int r = 0; r < 16; ++r) { p0[r] = __builtin_amdgcn_exp2f(p0[r] - mrun); p1[r] = __builtin_amdgcn_exp2f(p1[r] - mrun); rs += p0[r] + p1[r]; }
            lsum += rs;
            v4u pw[4];
#pragma unroll
            for (int k = 0; k < 2; ++k) {
                pw[k] = (v4u){pg8::cvtpk(p0[8 * k], p0[8 * k + 1]), pg8::cvtpk(p0[8 * k + 2], p0[8 * k + 3]), pg8::cvtpk(p0[8 * k + 4], p0[8 * k + 5]), pg8::cvtpk(p0[8 * k + 6], p0[8 * k + 7])};
                pw[2 + k] = (v4u){pg8::cvtpk(p1[8 * k], p1[8 * k + 1]), pg8::cvtpk(p1[8 * k + 2], p1[8 * k + 3]), pg8::cvtpk(p1[8 * k + 4], p1[8 * k + 5]), pg8::cvtpk(p1[8 * k + 6], p1[8 * k + 7])}; }
            const LAS unsigned char* vb = buf + 8192 + ((lane >> 4) & 1) * 32 + (lane & 3) * 8 + (4 * hi + ((lane & 15) >> 2)) * 64;
#pragma unroll
            for (int ks = 0; ks < 4; ++ks) {
                const s16x4 a0 = vtr(vb + ks * 1024), a1 = vtr(vb + ks * 1024 + 512), c0 = vtr(vb + 4096 + ks * 1024), c1 = vtr(vb + 4096 + ks * 1024 + 512);
                const bf16x8 va = (bf16x8){a0[0], a0[1], a0[2], a0[3], a1[0], a1[1], a1[2], a1[3]}, vc = (bf16x8){c0[0], c0[1], c0[2], c0[3], c1[0], c1[1], c1[2], c1[3]};
                const bf16x8 pf = __builtin_bit_cast(bf16x8, pw[ks]);
                o0 = __builtin_amdgcn_mfma_f32_32x32x16_bf16(va, pf, o0, 0, 0, 0); o1 = __builtin_amdgcn_mfma_f32_32x32x16_bf16(vc, pf, o1, 0, 0, 0); }
        }
    }
    const float linv = 1.0f / swapsum(lsum);
    bf16* orow = MIX + (rowbase + qpos) * D + 512 + h * 64;
#pragma unroll
    for (int g = 0; g < 4; ++g) { v2u w0, w1;
        w0.x = pk2(o0[4 * g] * linv, o0[4 * g + 1] * linv); w0.y = pk2(o0[4 * g + 2] * linv, o0[4 * g + 3] * linv);
        w1.x = pk2(o1[4 * g] * linv, o1[4 * g + 1] * linv); w1.y = pk2(o1[4 * g + 2] * linv, o1[4 * g + 3] * linv);
        *(v2u*)(orow + 8 * g + 4 * hi) = w0; *(v2u*)(orow + 32 + 8 * g + 4 * hi) = w1; }
    __syncthreads();
}

__device__ __forceinline__ void xattn_unit(const Args& A, int l, int unit, LAS unsigned char* L) {
    int tid = threadIdx.x; asm volatile("" : "+v"(tid));
    const bf16* Q = (const bf16*)(A.ws + WS_BIG); bf16* AO = (bf16*)(A.ws + WS_BIG + 64 * MiB);
    const bf16* Kb = (const bf16*)(A.ws + WS_KB) + (size_t)l * MROWS * D; const bf16* Vt = (const bf16*)(A.ws + WS_VT) + (size_t)l * D * MROWS;
    const int lane = tid & 63, r32 = lane & 31, hi = lane >> 5, wid = __builtin_amdgcn_readfirstlane(tid >> 6);
    const int bh = unit >> 3, qb = unit & 7, b = bh >> 2, h = bh & 3;
    const size_t qrow = (size_t)b * SEQ + qb * 256 + wid * 32 + r32;
    bf16x8 qf[16];
    {   v4u kr[16];
#pragma unroll
        for (int i = 0; i < 16; ++i) { const int e = tid + NTHR * i, key = e >> 5, ch = e & 31; kr[i] = *(const v4u*)(Kb + (size_t)(b * MEMLEN + key) * D + h * 256 + ch * 8); }
#pragma unroll
        for (int s = 0; s < 16; ++s) qf[s] = *(const bf16x8*)(Q + qrow * D + h * 256 + 16 * s + 8 * hi);
#pragma unroll
        for (int i = 0; i < 16; ++i) { const int e = tid + NTHR * i, key = e >> 5, ch = e & 31; *(LAS v4u*)(L + key * 528 + (ch << 4)) = kr[i]; } }
    __syncthreads();
    v4u pf[16]; float mh[2], lh[2];
    const LAS unsigned char* kbase = L + r32 * 528 + (hi << 4);
#pragma unroll
    for (int half = 0; half < 2; ++half) {
        f32x16 sc[4];
#pragma unroll
        for (int kt = 0; kt < 4; ++kt)
#pragma unroll
            for (int r = 0; r < 16; ++r) sc[kt][r] = 0.f;
        {   const LAS unsigned char* kh = kbase + (32 * 4 * half) * 528;
            bf16x8 cur[4], nxt[4];
#pragma unroll
            for (int j = 0; j < 4; ++j) cur[j] = *(const LAS bf16x8*)(kh + ((2 * j) << 4));
            __builtin_amdgcn_sched_barrier(0);
#pragma unroll
            for (int t = 0; t < 16; ++t) { const int sg = t >> 2, kt = t & 3;
                if (t < 15) { const int sg1 = (t + 1) >> 2, kt1 = (t + 1) & 3;
#pragma unroll
                    for (int j = 0; j < 4; ++j) nxt[j] = *(const LAS bf16x8*)(kh + (32 * kt1) * 528 + ((2 * (4 * sg1 + j)) << 4)); }
                __builtin_amdgcn_sched_barrier(0);
#pragma unroll
                for (int j = 0; j < 4; ++j) sc[kt] = __builtin_amdgcn_mfma_f32_32x32x16_bf16(cur[j], qf[4 * sg + j], sc[kt], 0, 0, 0);
                __builtin_amdgcn_sched_barrier(0);
                if (t < 15) {
#pragma unroll
                    for (int j = 0; j < 4; ++j) cur[j] = nxt[j]; } } }
        float rm = -INFINITY;
#pragma unroll
        for (int kt = 0; kt < 4; ++kt)
#pragma unroll
            for (int r = 0; r < 16; ++r) rm = fmaxf(rm, sc[kt][r]);
        rm = swapmax(rm); mh[half] = rm;
        float ls = 0.f;
#pragma unroll
        for (int kt = 0; kt < 4; ++kt) {
#pragma unroll
            for (int r = 0; r < 16; ++r) { sc[kt][r] = __builtin_amdgcn_exp2f(sc[kt][r] - rm); ls += sc[kt][r]; }
#pragma unroll
            for (int k = 0; k < 2; ++k) pf[8 * half + 2 * kt + k] = (v4u){pg8::cvtpk(sc[kt][8 * k], sc[kt][8 * k + 1]), pg8::cvtpk(sc[kt][8 * k + 2], sc[kt][8 * k + 3]), pg8::cvtpk(sc[kt][8 * k + 4], sc[kt][8 * k + 5]), pg8::cvtpk(sc[kt][8 * k + 6], sc[kt][8 * k + 7])}; }
        lh[half] = swapsum(ls);
        asm volatile("" ::: "memory");
    }
    const float mx = fmaxf(mh[0], mh[1]), f0 = __builtin_amdgcn_exp2f(mh[0] - mx), f1 = __builtin_amdgcn_exp2f(mh[1] - mx);
    const float linv = 1.0f / (f0 * lh[0] + f1 * lh[1]); const float w0 = f0 * linv, w1 = f1 * linv;
    v4u vr[16];
#pragma unroll
    for (int i = 0; i < 16; ++i) { const int e = tid + NTHR * i, d = e >> 5, ch = e & 31; vr[i] = *(const v4u*)(Vt + (size_t)(h * 256 + d) * MROWS + b * MEMLEN + ch * 8); }
    __syncthreads();
#pragma unroll
    for (int i = 0; i < 16; ++i) { const int e = tid + NTHR * i, d = e >> 5, ch = e & 31; const v4u v = vr[i];
        *(LAS v2u*)(L + d * 520 + (ch << 4)) = (v2u){v.x, v.y}; *(LAS v2u*)(L + d * 520 + (ch << 4) + 8) = (v2u){v.z, v.w}; }
    __syncthreads();
    bf16* orow = AO + qrow * D + h * 256;
    const int pr32 = 16 * ((r32 >> 2) & 1) + 4 * (r32 >> 3) + (r32 & 3);
    bf16x8 cur[4], nxt[4];
#define XV_LOAD(f, dt_, q_) { const LAS unsigned char* rowp = L + (32 * (dt_) + pr32) * 520 + (hi << 3); _Pragma("unroll") for (int j = 0; j < 4; ++j) { const int ks = 2 * (q_) + (j >> 1) + 8 * (j & 1); \
        const v2u lo = *(const LAS v2u*)(rowp + (ks << 5)), hh = *(const LAS v2u*)(rowp + (ks << 5) + 16); f[j] = __builtin_bit_cast(bf16x8, (v4u){lo.x, lo.y, hh.x, hh.y}); } }
    XV_LOAD(cur, 0, 0);
    __builtin_amdgcn_sched_barrier(0);
#pragma unroll 1
    for (int dt = 0; dt < 8; ++dt) { f32x16 o0, o1;
#pragma unroll
        for (int r = 0; r < 16; ++r) { o0[r] = 0.f; o1[r] = 0.f; }
#pragma unroll
        for (int q = 0; q < 4; ++q) {
            if (q < 3) XV_LOAD(nxt, dt, q + 1) else XV_LOAD(nxt, (dt + 1) & 7, 0)
            __builtin_amdgcn_sched_barrier(0);
#pragma unroll
            for (int j = 0; j < 4; ++j) { const int ks = 2 * q + (j >> 1) + 8 * (j & 1);
                if (j & 1) o1 = __builtin_amdgcn_mfma_f32_32x32x16_bf16(cur[j], __builtin_bit_cast(bf16x8, pf[ks]), o1, 0, 0, 0);
                else o0 = __builtin_amdgcn_mfma_f32_32x32x16_bf16(cur[j], __builtin_bit_cast(bf16x8, pf[ks]), o0, 0, 0, 0); }
            __builtin_amdgcn_sched_barrier(0);
#pragma unroll
            for (int j = 0; j < 4; ++j) cur[j] = nxt[j]; }
#pragma unroll
        for (int g = 0; g < 2; ++g) { v4u w;
            w.x = pk2(o0[8 * g] * w0 + o1[8 * g] * w1, o0[8 * g + 1] * w0 + o1[8 * g + 1] * w1); w.y = pk2(o0[8 * g + 2] * w0 + o1[8 * g + 2] * w1, o0[8 * g + 3] * w0 + o1[8 * g + 3] * w1);
            w.z = pk2(o0[8 * g + 4] * w0 + o1[8 * g + 4] * w1, o0[8 * g + 5] * w0 + o1[8 * g + 5] * w1); w.w = pk2(o0[8 * g + 6] * w0 + o1[8 * g + 6] * w1, o0[8 * g + 7] * w0 + o1[8 * g + 7] * w1);
            *(v4u*)(orow + 32 * dt + 16 * hi + 8 * g) = w; } }
    __syncthreads();
}

__device__ __forceinline__ void lr_phase(const Args& A, int l, const pg8::u64_t* ssq, int G) {
    typedef _Float16 h8 __attribute__((ext_vector_type(8)));
    int tid = threadIdx.x; asm volatile("" : "+v"(tid));
    const int lane = tid & 63, wave = __builtin_amdgcn_readfirstlane(tid >> 6), i16 = lane & 15, kq = lane >> 4;
    const _Float16* X = (const _Float16*)(A.ws + WS_XB); const _Float16* W = (const _Float16*)(A.ws + WS_WLR) + (size_t)l * 16 * D; bf16* LR = (bf16*)(A.ws + WS_LR);
    for (int rb = blockIdx.x * NWAVES + wave; rb < M / 16; rb += G * NWAVES) {
        const _Float16* xa = X + (size_t)(rb * 16 + i16) * D + 8 * kq; const _Float16* wb = W + (size_t)i16 * D + 8 * kq;
        f32x4 acc = (f32x4){0.f, 0.f, 0.f, 0.f};
        h8 a[32];
#pragma unroll
        for (int s = 0; s < 32; ++s) a[s] = *(const h8*)(xa + 32 * s);
#pragma unroll
        for (int s0 = 0; s0 < 32; s0 += 8) { h8 b[8];
#pragma unroll
            for (int s = 0; s < 8; ++s) b[s] = *(const h8*)(wb + 32 * (s0 + s));
#pragma unroll
            for (int s = 0; s < 8; ++s) acc = __builtin_amdgcn_mfma_f32_16x16x32_f16(a[s0 + s], b[s], acc, 0, 0, 0); }
#pragma unroll
        for (int r = 0; r < 4; ++r) { const int row = rb * 16 + 4 * kq + r; LR[(size_t)row * 16 + i16] = (bf16)f2bf(acc[r] * pg8::rstd_from(ssq[row])); }
    }
}

typedef const Args __attribute__((address_space(4))) KArgs;
__device__ __forceinline__ Args phase_args() {
#if defined(__HIP_DEVICE_COMPILE__)
    KArgs* kp = (KArgs*)__builtin_amdgcn_kernarg_segment_ptr(); asm volatile("" : "+s"(kp));
    Args a;
#pragma unroll
    for (int i = 0; i < 27; ++i) a.in[i] = kp->in[i];
    a.out = kp->out; a.ws = kp->ws; return a;
#else
    return Args{};
#endif
}
#define PH_ARGS const Args args = phase_args(); unsigned char* const ws = args.ws; unsigned* const ctl = (unsigned*)(ws + WS_CTL); u64* const ssq = (u64*)(ws + WS_SSQ); \
    bf16* const XB = (bf16*)(ws + WS_XB); bf16* const MIX = (bf16*)(ws + WS_MIX); bf16* const BIG = (bf16*)(ws + WS_BIG); const float* const cs = (const float*)(ws + WS_ROPE); const float* const sn = cs + (size_t)M * 8; \
    (void)ctl; (void)ssq; (void)XB; (void)MIX; (void)BIG; (void)cs; (void)sn
__global__ void __launch_bounds__(NTHR, 2) hybrid_fwd(Args kernel_args) {
    extern __shared__ __attribute__((aligned(16))) unsigned char lds_raw[];
    LAS unsigned char* L = (LAS unsigned char*)lds_raw;
    volatile LAS unsigned* MISC = (volatile LAS unsigned*)(L + MISC_OFF);
    const int G = gridDim.x;
    for (int u = threadIdx.x; u < (LDS_BYTES - 139264) / 4; u += NTHR) ((LAS unsigned*)(L + 139264))[u] = 0u;
    __syncthreads();
    XcdBarrier bar = xcd_barrier_post((unsigned*)(kernel_args.ws + WS_CTL) + CW_BAR, MISC + 8);

    { PH_ARGS; p0_prologue(args, L, G); }
    xcd_barrier(bar);

    {   PH_ARGS; pg8::Gemm g{(const bf16*)(ws + WS_MEMN), (const bf16*)(ws + WS_WK), DEPTH * MROWS, DEPTH * D, D}; pg8::DiagOrder S{16, 4, DEPTH, G, (int)blockIdx.x};
        pg8::EpiKV E{(bf16*)(ws + WS_KB), D, 16, 4, (size_t)MROWS * D};
        pg8::gemm_phase<pg8::EpiKV, pg8::DiagOrder, true, true>(L, g, S, E); }
    {   PH_ARGS; pg8::Gemm g{(const bf16*)(ws + WS_WV), (const bf16*)(ws + WS_MEMN), DEPTH * D, DEPTH * MROWS, D}; pg8::DiagOrder S{4, 16, DEPTH, G, (int)((blockIdx.x + 128) % G)};
        pg8::EpiKV E{(bf16*)(ws + WS_VT), MROWS, 4, 16, (size_t)D * MROWS};
        pg8::gemm_phase<pg8::EpiKV, pg8::DiagOrder, true, true>(L, g, S, E); }

    for (int l = 0; l < DEPTH; ++l) {
        {   PH_ARGS; pg8::Gemm g{XB, (const bf16*)(ws + WS_W1 + l * SZ_W1), M, NUP, D}; pg8::StaticOrder S; S.init(M, NUP, G, (int)blockIdx.x);
            pg8::EpiSwiglu E{BIG, DFF, ssq + (size_t)(4 * l) * M};
            pg8::gemm_phase<pg8::EpiSwiglu, pg8::StaticOrder, true, true, true>(L, g, S, E); }
        xcd_barrier(bar);
        {   PH_ARGS; pg8::Gemm g{BIG, (const bf16*)(ws + WS_W2 + l * SZ_W2), M, D, DFF}; pg8::StaticOrder S; S.init(M, D, G, (int)blockIdx.x);
            pg8::EpiResid E{l == 0 ? args.in[0] : nullptr, XB, ssq + (size_t)(4 * l + 1) * M, 0.5f};
            pg8::gemm_phase<pg8::EpiResid, pg8::StaticOrder, true, true>(L, g, S, E); }
        xcd_barrier(bar);
        {   PH_ARGS; pg8::Gemm g{XB, (const bf16*)(ws + WS_WIN + l * SZ_WIN), M, NIN, D}; pg8::StaticOrder S; S.init(M, NIN, G, (int)blockIdx.x);
            pg8::EpiProj E{BIG, NIN, ssq + (size_t)(4 * l + 1) * M, cs, sn, C_DQ / 256, C_DK / 256, 0.125f * LOG2E, 1.0f};
            pg8::gemm_phase<pg8::EpiProj, pg8::StaticOrder, true, true, true>(L, g, S, E);
            lr_phase(args, l, ssq + (size_t)(4 * l + 1) * M, G);
            }
        xcd_barrier(bar);
        {   PH_ARGS;
            {   int tidl = threadIdx.x; asm volatile("" : "+v"(tidl)); const int wave = __builtin_amdgcn_readfirstlane(tidl >> 6); LAS unsigned char* WL = L + wave * 16384;
                for (int task = blockIdx.x * NWAVES + wave; task < 2048; task += G * NWAVES) { scan_taskA<64, true>(args, l, task >> 5, task & 31, WL); scan_taskA<32, false>(args, l, task >> 5, task & 31, WL); } }
            __syncthreads();
            for (int u = blockIdx.x; u < 1024; u += G) conv_unit(args, l, u, L);
            }
        xcd_barrier(bar);
        {   PH_ARGS;
            scan_phaseB(args, G);
            for (int p = blockIdx.x; p < 256; p += G) { const int bh = p & 63, k = p >> 6;
                dattn_unit(args, bh * 8 + 7 - k, L); dattn_unit(args, bh * 8 + k, L); }
            }
        xcd_barrier(bar);
        {   PH_ARGS; int tidl = threadIdx.x; asm volatile("" : "+v"(tidl)); const int wave = __builtin_amdgcn_readfirstlane(tidl >> 6); LAS unsigned char* WL = L + wave * 16384;
            for (int task = blockIdx.x * NWAVES + wave; task < 2048; task += G * NWAVES) { scan_taskC<64, true>(args, l, task >> 5, task & 31, WL); scan_taskC<32, false>(args, l, task >> 5, task & 31, WL); } }
        xcd_barrier(bar);
        {   PH_ARGS; pg8::Gemm g{MIX, (const bf16*)(ws + WS_WOUT + l * SZ_SQ), M, D, D}; pg8::StaticOrder S; S.init(M, D, G, (int)blockIdx.x);
            pg8::EpiResid E{nullptr, XB, ssq + (size_t)(4 * l + 2) * M, 1.0f};
            pg8::gemm_phase<pg8::EpiResid, pg8::StaticOrder, true, true>(L, g, S, E); }
        xcd_barrier(bar);
        {   PH_ARGS; pg8::Gemm g{XB, (const bf16*)(ws + WS_WQ + l * SZ_SQ), M, D, D}; pg8::StaticOrder S; S.init(M, D, G, (int)blockIdx.x);
            pg8::EpiProj E{BIG, D, ssq + (size_t)(4 * l + 2) * M, cs, sn, -1, -1, 1.0f, 0.0625f * LOG2E};
            pg8::gemm_phase<pg8::EpiProj, pg8::StaticOrder, true, true, true>(L, g, S, E); }
        __syncthreads();
        {   PH_ARGS; pg8::StaticOrder S; S.init(M, D, G, (int)blockIdx.x); pg8::Unit u;
            for (int i = 0; S.next(i, u); ++i) xattn_unit(args, l, ((u.pm >> 3) * 4 + u.pn) * 8 + (u.pm & 7), L); }
        xcd_barrier(bar);
        {   PH_ARGS; pg8::Gemm g{(const bf16*)(ws + WS_BIG + 64 * MiB), (const bf16*)(ws + WS_WO + l * SZ_SQ), M, D, D}; pg8::StaticOrder S; S.init(M, D, G, (int)blockIdx.x);
            pg8::EpiResid E{nullptr, XB, ssq + (size_t)(4 * l + 3) * M, 1.0f};
            pg8::gemm_phase<pg8::EpiResid, pg8::StaticOrder, true, true>(L, g, S, E); }
        xcd_barrier(bar);
        {   PH_ARGS; pg8::Gemm g{XB, (const bf16*)(ws + WS_W3 + l * SZ_W1), M, NUP, D}; pg8::StaticOrder S; S.init(M, NUP, G, (int)blockIdx.x);
            pg8::EpiSwiglu E{BIG, DFF, ssq + (size_t)(4 * l + 3) * M};
            pg8::gemm_phase<pg8::EpiSwiglu, pg8::StaticOrder, true, true, true>(L, g, S, E); }
        xcd_barrier(bar);
        {   PH_ARGS; pg8::Gemm g{BIG, (const bf16*)(ws + WS_W4 + l * SZ_W2), M, D, DFF}; pg8::StaticOrder S; S.init(M, D, G, (int)blockIdx.x);
            pg8::EpiResid E{nullptr, XB, ssq + (size_t)(4 * l + 4) * M, 0.5f};
            pg8::gemm_phase<pg8::EpiResid, pg8::StaticOrder, true, true>(L, g, S, E); }
        xcd_barrier(bar);
    }
    {   PH_ARGS;
        int tid = threadIdx.x; asm volatile("" : "+v"(tid));
        const int lane = tid & 63, wave = __builtin_amdgcn_readfirstlane(tid >> 6);
        const int gw = blockIdx.x * NWAVES + wave, NGW = G * NWAVES;
        const f32x4* gr = (const f32x4*)args.in[26] + lane;
        f32x4 gv[4];
#pragma unroll
        for (int j = 0; j < 4; ++j) gv[j] = gr[64 * j];
        for (int m = gw; m < M; m += 4 * NGW) {
            v2u hv[4][4];
#pragma unroll
            for (int q = 0; q < 4; ++q) { const int mq = m + q * NGW < M ? m + q * NGW : m; const v2u* hr = (const v2u*)(XB + (size_t)mq * D) + lane;
#pragma unroll
                for (int j = 0; j < 4; ++j) hv[q][j] = hr[64 * j]; }
#pragma unroll
            for (int q = 0; q < 4; ++q) { const int mq = m + q * NGW; if (mq >= M) break; f32x4* orow = (f32x4*)(args.out + (size_t)mq * D) + lane; f32x4 v[4]; float ss = 0.f;
#pragma unroll
                for (int j = 0; j < 4; ++j) { const pg8::f32x2 a = pg8::unpk_h(hv[q][j].x), b = pg8::unpk_h(hv[q][j].y); v[j] = (f32x4){a.x, a.y, b.x, b.y}; ss += (v[j][0] * v[j][0] + v[j][1] * v[j][1]) + (v[j][2] * v[j][2] + v[j][3] * v[j][3]); }
                const float rs = 1.0f / sqrtf(wave_sum(ss) * (1.0f / D) + EPS);
#pragma unroll
                for (int j = 0; j < 4; ++j) __builtin_nontemporal_store(v[j] * rs * gv[j], &orow[64 * j]); } }
    }
}

extern "C" void kernel_launch(void* const* d_in, const int* in_sizes, int n_in, void* d_out, int out_size, void* d_ws, size_t ws_size, hipStream_t stream) {
    static int grid = 0;
    if (grid == 0) {
        if (n_in != 27 || out_size != M * D || ws_size < WS_END) { fprintf(stderr, "kernel_launch: unexpected problem (n_in %d, out %d, ws %zu)\n", n_in, out_size, ws_size); grid = -1; return; }
        int dev = 0, cus = 0, per_cu = 0;
        if (hipGetDevice(&dev) != hipSuccess || hipDeviceGetAttribute(&cus, hipDeviceAttributeMultiprocessorCount, dev) != hipSuccess) { grid = -1; return; }
        if (hipFuncSetAttribute((const void*)hybrid_fwd, hipFuncAttributeMaxDynamicSharedMemorySize, LDS_BYTES) != hipSuccess) { fprintf(stderr, "kernel_launch: hipFuncSetAttribute failed\n"); grid = -1; return; }
        if (hipOccupancyMaxActiveBlocksPerMultiprocessor(&per_cu, (const void*)hybrid_fwd, NTHR, LDS_BYTES) != hipSuccess || per_cu < 1) { fprintf(stderr, "kernel_launch: occupancy query reports %d\n", per_cu); }
        (void)hipGetLastError();
        grid = cus;
    }
    if (grid < 0) return;
    if (hipMemsetAsync((char*)d_ws + WS_CTL, 0, CTL_ZERO_BYTES, stream) != hipSuccess) return;
    Args a{};
    for (int i = 0; i < 27; ++i) a.in[i] = (const float*)d_in[i];
    a.out = (float*)d_out; a.ws = (unsigned char*)d_ws;
    hipLaunchKernelGGL(hybrid_fwd, dim3(grid), dim3(NTHR), LDS_BYTES, stream, a);
}
```
